# Optimizing an MI355X kernel written in HIP

```python
import math
import jax, jax.numpy as jnp
from jax import lax
import numpy as np

D_MODEL = 2048
BATCH = 8
SEQ = 2048
DEPTH = 1

ATTN_HEADS = 8
ATTN_HEAD_DIM = 64
ATTN_V_DIM = 2 * ATTN_HEAD_DIM
ATTN_QK_WIDTH = 2 * ATTN_HEADS * ATTN_HEAD_DIM
ATTN_WIDTH = ATTN_HEADS * ATTN_V_DIM
ROPE_THETA = 500000.0
ROT_DIM = ATTN_HEAD_DIM // 4
Q_BLOCK = 128
REC_EXPAND = 128
REC_WIDTH = D_MODEL // 2
REC_HEADS = REC_WIDTH // REC_EXPAND
REC_V_DIM = REC_WIDTH // REC_HEADS
REC_FORGET = REC_HEADS * REC_EXPAND
CHUNK = 64
D_FF = 5632
EPS = 1e-6
IN_SIZES = (ATTN_QK_WIDTH, ATTN_QK_WIDTH, ATTN_WIDTH,
            REC_FORGET, REC_FORGET, REC_WIDTH, REC_WIDTH,
            D_MODEL, D_MODEL)
IN_COLS = sum(IN_SIZES)

kernel_name = "hybrid_diffattn_hgrn2_macaron"


def rmsnorm(x, w):
    xf = x.astype(jnp.float32)
    y = xf * lax.rsqrt(jnp.mean(xf * xf, axis=-1, keepdims=True) + EPS)
    return (y * w.astype(jnp.float32)).astype(x.dtype)


def swiglu(h, w_in, w_out):
    gate, up = jnp.split(h @ w_in, 2, axis=-1)
    return (jax.nn.silu(gate) * up) @ w_out


def rope_partial(x, pos):
    inv_freq = ROPE_THETA ** (-jnp.arange(0, ROT_DIM, 2, dtype=jnp.float32) / ROT_DIM)
    ang = pos.astype(jnp.float32)[:, None] * inv_freq[None, :]
    ang = jnp.concatenate([ang, ang], axis=-1)[None, :, None, :]
    cos, sin = jnp.cos(ang), jnp.sin(ang)
    xr = x[..., :ROT_DIM].astype(jnp.float32)
    x1, x2 = jnp.split(xr, 2, axis=-1)
    rot = jnp.concatenate([-x2, x1], axis=-1)
    xr = (xr * cos + rot * sin).astype(x.dtype)
    return jnp.concatenate([xr, x[..., ROT_DIM:]], axis=-1)


def diff_attention(q, k, v, lq1, lk1, lq2, lk2, subln_w, layer):
    B, S, _ = q.shape
    H, d = ATTN_HEADS, ATTN_HEAD_DIM
    lambda_init = 0.8 - 0.6 * math.exp(-0.3 * layer)
    pos = jnp.arange(S)
    q = rope_partial(q.reshape(B, S, 2 * H, d), pos)
    k = rope_partial(k.reshape(B, S, 2 * H, d), pos)
    v = v.reshape(B, S, H, ATTN_V_DIM).transpose(0, 2, 1, 3)
    q = q.transpose(0, 2, 1, 3) * (d ** -0.5)
    k = k.transpose(0, 2, 1, 3)
    nb = S // Q_BLOCK
    qb = q.reshape(B, 2 * H, nb, Q_BLOCK, d).transpose(2, 0, 1, 3, 4)
    lam = (jnp.exp(jnp.sum(lq1.astype(jnp.float32) * lk1.astype(jnp.float32)))
           - jnp.exp(jnp.sum(lq2.astype(jnp.float32) * lk2.astype(jnp.float32)))
           + lambda_init)
    key_pos = jnp.arange(S)

    def block(args):
        i, qblk = args
        s = jnp.einsum('bhqd,bhkd->bhqk', qblk, k).astype(jnp.float32)
        q_pos = i * Q_BLOCK + jnp.arange(Q_BLOCK)
        s = jnp.where(q_pos[:, None] >= key_pos[None, :], s, -jnp.inf)
        p = jax.nn.softmax(s, axis=-1).reshape(B, H, 2, Q_BLOCK, S)
        w = p[:, :, 0] - lam * p[:, :, 1]
        return jnp.einsum('bhqk,bhkv->bhqv', w.astype(v.dtype), v)

    o = lax.map(block, (jnp.arange(nb), qb))
    o = o.transpose(1, 0, 3, 2, 4).reshape(B, S, H, ATTN_V_DIM)
    o = rmsnorm(o, subln_w) * (1.0 - lambda_init)
    return o.reshape(B, S, ATTN_WIDTH)


def hgrn2(q, fl, i, g, lb, gnorm_w):
    B, S, _ = q.shape
    H, K, V = REC_HEADS, REC_EXPAND, REC_V_DIM
    qf = jax.nn.silu(q.astype(jnp.float32)).reshape(B, S, H, K)
    lbh = lb.reshape(H, K)
    f = lbh + (1.0 - lbh) * jax.nn.sigmoid(fl.astype(jnp.float32).reshape(B, S, H, K))
    logf = jnp.log(f)
    kf = 1.0 - f
    vf = i.astype(jnp.float32).reshape(B, S, H, V)
    nc = S // CHUNK

    def to_chunks(t):
        return t.reshape(B, nc, CHUNK, H, -1).transpose(1, 0, 3, 2, 4)

    causal = jnp.tril(jnp.ones((CHUNK, CHUNK), dtype=bool))

    def step(state, inp):
        qc, kc, vc, gc = inp
        G = jnp.cumsum(gc, axis=2)
        inter = jnp.einsum('bhck,bhkv->bhcv', qc * jnp.exp(G), state)
        rel = G[:, :, :, None, :] - G[:, :, None, :, :]
        decay = jnp.exp(jnp.where(causal[:, :, None], rel, -jnp.inf))
        A = jnp.einsum('bhtk,bhsk,bhtsk->bhts', qc, kc, decay)
        intra = jnp.einsum('bhts,bhsv->bhtv', A, vc)
        G_last = G[:, :, -1:, :]
        new_state = (jnp.exp(G_last[:, :, 0, :])[..., None] * state
                     + jnp.einsum('bhsk,bhsv->bhkv', kc * jnp.exp(G_last - G), vc))
        return new_state, inter + intra

    s0 = jnp.zeros((B, H, K, V), jnp.float32)
    _, o = lax.scan(step, s0, (to_chunks(qf), to_chunks(kf), to_chunks(vf), to_chunks(logf)))
    o = o.transpose(1, 0, 3, 2, 4).reshape(B, S, H, V)
    o = rmsnorm(o, gnorm_w) * jax.nn.silu(g.astype(jnp.float32).reshape(B, S, H, V))
    return o.reshape(B, S, REC_WIDTH).astype(q.dtype)


def setup_inputs(seed: int = 0) -> dict:
    key = jax.random.key(seed)
    ks = jax.random.split(key, 24)
    f32 = jnp.float32

    def dense(k, shape, fan_in):
        return jax.random.normal(k, shape, f32) * (fan_in ** -0.5)

    def gain(k, shape):
        return 1.0 + 0.01 * jax.random.normal(k, shape, f32)

    return {
        "x": jax.random.normal(ks[0], (BATCH, SEQ, D_MODEL), f32),
        "ffn1_norm": gain(ks[1], (DEPTH, D_MODEL)),
        "ffn1_in": dense(ks[2], (DEPTH, D_MODEL, 2 * D_FF), D_MODEL),
        "ffn1_out": dense(ks[3], (DEPTH, D_FF, D_MODEL), D_FF),
        "mix_norm": gain(ks[4], (DEPTH, D_MODEL)),
        "w_in": dense(ks[5], (DEPTH, D_MODEL, IN_COLS), D_MODEL),
        "lambda_q1": 0.1 * jax.random.normal(ks[6], (DEPTH, ATTN_HEAD_DIM), f32),
        "lambda_k1": 0.1 * jax.random.normal(ks[7], (DEPTH, ATTN_HEAD_DIM), f32),
        "lambda_q2": 0.1 * jax.random.normal(ks[8], (DEPTH, ATTN_HEAD_DIM), f32),
        "lambda_k2": 0.1 * jax.random.normal(ks[9], (DEPTH, ATTN_HEAD_DIM), f32),
        "attn_subln": gain(ks[10], (DEPTH, ATTN_V_DIM)),
        "rec_lb_raw": 0.1 * jax.random.normal(ks[11], (DEPTH + 1, REC_FORGET), f32),
        "rec_gnorm": gain(ks[12], (DEPTH, REC_V_DIM)),
        "w_proj_attn": dense(ks[13], (DEPTH, ATTN_WIDTH, D_MODEL), ATTN_WIDTH),
        "w_proj_rec": dense(ks[14], (DEPTH, REC_WIDTH, D_MODEL), REC_WIDTH),
        "w_out": dense(ks[15], (DEPTH, D_MODEL, D_MODEL), D_MODEL),
        "ffn2_norm": gain(ks[16], (DEPTH, D_MODEL)),
        "ffn2_in": dense(ks[17], (DEPTH, D_MODEL, 2 * D_FF), D_MODEL),
        "ffn2_out": dense(ks[18], (DEPTH, D_FF, D_MODEL), D_FF),
        "final_norm": gain(ks[19], (D_MODEL,)),
    }


def reference(x, ffn1_norm, ffn1_in, ffn1_out, mix_norm, w_in, lambda_q1, lambda_k1,
              lambda_q2, lambda_k2, attn_subln, rec_lb_raw, rec_gnorm, w_proj_attn,
              w_proj_rec, w_out, ffn2_norm, ffn2_in, ffn2_out, final_norm):
    lower_bounds = jnp.cumsum(jax.nn.softmax(rec_lb_raw.astype(jnp.float32), axis=0), axis=0)
    split_at = [int(c) for c in np.cumsum(IN_SIZES)[:-1]]
    for l in range(DEPTH):
        x = x + 0.5 * swiglu(rmsnorm(x, ffn1_norm[l]), ffn1_in[l], ffn1_out[l])
        h = rmsnorm(x, mix_norm[l])
        q_a, k_a, v_a, q_r, f_r, i_r, g_r, gate_a, gate_b = jnp.split(h @ w_in[l], split_at, axis=-1)
        y_a = diff_attention(q_a, k_a, v_a, lambda_q1[l], lambda_k1[l], lambda_q2[l],
                             lambda_k2[l], attn_subln[l], l)
        y_r = hgrn2(q_r, f_r, i_r, g_r, lower_bounds[l], rec_gnorm[l])
        merged = (jax.nn.sigmoid(gate_a) * (y_a @ w_proj_attn[l])
                  + jax.nn.sigmoid(gate_b) * (y_r @ w_proj_rec[l]))
        x = x + merged @ w_out[l]
        x = x + 0.5 * swiglu(rmsnorm(x, ffn2_norm[l]), ffn2_in[l], ffn2_out[l])
    return rmsnorm(x, final_norm)
```

```cpp
#include <hip/hip_runtime.h>
#include <cstdio>
#include <cstdint>
namespace pg8 {
#define PG8_LAS __attribute__((address_space(3)))
typedef unsigned short bf16_t;
typedef short bf16x8 __attribute__((ext_vector_type(8)));
typedef float f32x4 __attribute__((ext_vector_type(4)));
typedef unsigned u32x4 __attribute__((ext_vector_type(4)));
constexpr int BM = 256, BK = 64, HALF = 128, HTB = HALF * BK * 2  , STAGE_BYTES = 8 * HTB, NXCD = 8, WGM = 8;

__host__ __device__ __forceinline__ int lds_byte(int r, int c) { const int st = (r >> 4) * 2 + (c >> 5), rr = r & 15, cc = c & 31, ob = rr * 64 + cc * 2; return st * 1024 + (ob ^ (((ob >> 9) & 1) << 5)); }
__host__ __device__ __forceinline__ void stage_rc(int b, int& R, int& C) { const int st = b / 1024, sb = b % 1024, swz = sb ^ (((sb >> 9) & 1) << 5); R = (st >> 1) * 16 + swz / 64; C = (st & 1) * 32 + (swz % 64) / 2; }
__host__ __device__ __forceinline__ int perm32(int rho) { const int n = rho >> 4, i = rho & 15; return 8 * (i >> 2) + 4 * n + (i & 3); }

struct Unit { int pm, pn; };
struct Gemm { const bf16_t* A; const bf16_t* Bt; int M, N, K; };

struct StaticOrder {
    int nM, nN, nwg, G, c;
    __host__ __device__ void init(int M, int N, int G_, int c_) { nM = M / BM; nN = N / BM; nwg = nM * nN; G = G_; c = c_; }
    __host__ __device__ bool next(int i, Unit& u) const {
        const long L = (long)i * G + c; if (L >= nwg) return false;
        int wgid = (int)L; { const int q = nwg / NXCD, r = nwg % NXCD, xcd = wgid % NXCD, off = wgid / NXCD; wgid = (xcd < r ? xcd * (q + 1) : r * (q + 1) + (xcd - r) * q) + off; }
        const int nig = WGM * nN, gid = wgid / nig, fm = gid * WGM, gsz = (nM - fm) < WGM ? (nM - fm) : WGM;
        u.pm = fm + ((wgid % nig) % gsz); u.pn = (wgid % nig) / gsz; return true;
    }
    __device__ __forceinline__ void a_ready(const Unit&) const {}
    __device__ __forceinline__ void done(const Unit&) const {}
};

__device__ __forceinline__ unsigned cvt_pk_bf16(float lo, float hi) { unsigned r; asm volatile("v_cvt_pk_bf16_f32 %0, %1, %2" : "=v"(r) : "v"(lo), "v"(hi)); return r; }
typedef float f32x2 __attribute__((ext_vector_type(2)));
template <class Epi, class Sched, bool ALIGN_EPI = false, bool SP2 = false>
__device__ __forceinline__ void gemm_phase(PG8_LAS unsigned char* lds, const Gemm g, const Sched& S, const Epi& E) {
    int tid_ = threadIdx.x; asm volatile("" : "+v"(tid_));
    const int tid = tid_, wid = __builtin_amdgcn_readfirstlane(tid >> 6), lane = tid & 63, wr = wid >> 2, wc = wid & 3, fr = lane & 15, fq = lane >> 4;
    const int K = g.K, nt = K / BK;
    unsigned voffA[2], voffB[2];
#pragma unroll
    for (int i = 0; i < 2; ++i) { int R, C; stage_rc(tid * 16 + i * 8192, R, C); const int Rb = Epi::PERM ? ((R & ~31) + perm32(R & 31)) : R;
        voffA[i] = (unsigned)(R * K + C) * 2u; voffB[i] = (unsigned)(Rb * K + C) * 2u; }
    const size_t kstep = (size_t)(BK * 2);
    const size_t hstep = (size_t)HALF * K * 2;
    const size_t tstep = 2 * hstep;
    const unsigned ldsw = (unsigned)wid * 1024u;
    const int aoff = lds_byte(wr * 64 + fr, fq * 8), boff = lds_byte(wc * 32 + fr, fq * 8);
#define PG8_SA(b, h) (((b) * 2 + (h)) * HTB)
#define PG8_SB(b, h) ((4 + (b) * 2 + (h)) * HTB)
#define PG8_STAGE(bufoff, gbase, voff) do { _Pragma("unroll") for (int _i = 0; _i < 2; ++_i) \
        __builtin_amdgcn_global_load_lds((const unsigned*)((const char*)(gbase) + (voff)[_i]), (PG8_LAS unsigned*)(lds + (bufoff) + ldsw + _i * 8192), 16, 0, 0); } while (0)
#define PG8_LDA(dst, b, h) do { _Pragma("unroll") for (int m = 0; m < 4; ++m) _Pragma("unroll") for (int k = 0; k < 2; ++k) dst[m][k] = *(const PG8_LAS bf16x8*)(lds + PG8_SA(b, h) + aoff + m * 2048 + k * 1024); } while (0)
#define PG8_LDB(dst, b, h) do { _Pragma("unroll") for (int n = 0; n < 2; ++n) _Pragma("unroll") for (int k = 0; k < 2; ++k) dst[n][k] = *(const PG8_LAS bf16x8*)(lds + PG8_SB(b, h) + boff + n * 2048 + k * 1024); } while (0)
#define PG8_MMA(ai, bj, At, Bt) do { __builtin_amdgcn_s_setprio(1); _Pragma("unroll") for (int m = 0; m < 4; ++m) _Pragma("unroll") for (int n = 0; n < 2; ++n) _Pragma("unroll") for (int k = 0; k < 2; ++k) \
        acc[ai][bj][m][n] = __builtin_amdgcn_mfma_f32_16x16x32_bf16(Bt[n][k], At[m][k], acc[ai][bj][m][n], 0, 0, 0); __builtin_amdgcn_s_setprio(0); } while (0)
#define PG8_WAIT_V(n) asm volatile("s_waitcnt vmcnt(" #n ")" ::: "memory")
#define PG8_WAIT_L(n) asm volatile("s_waitcnt lgkmcnt(" #n ")" ::: "memory")
#define PG8_BAR __builtin_amdgcn_s_barrier()
#define PG8_SCHED __builtin_amdgcn_sched_barrier(0)
    Unit cur, nxt; int ui = 0;
    if (!S.next(0, cur)) return;
    f32x4 acc[2][2][4][2];
#pragma unroll
    for (int a = 0; a < 2; ++a)
#pragma unroll
        for (int b = 0; b < 2; ++b)
#pragma unroll
            for (int m = 0; m < 4; ++m)
#pragma unroll
                for (int n = 0; n < 2; ++n) acc[a][b][m][n] = (f32x4){0.f, 0.f, 0.f, 0.f};
    bf16x8 At[4][2], B0[2][2], B1[2][2];
    const char* cA = (const char*)g.A + (size_t)cur.pm * tstep; const char* cB = (const char*)g.Bt + (size_t)cur.pn * tstep;
    S.a_ready(cur);
    if constexpr (SP2) {
        PG8_STAGE(PG8_SB(0, 0), cB, voffB); PG8_STAGE(PG8_SB(0, 1), cB + hstep, voffB); PG8_STAGE(PG8_SA(0, 0), cA, voffA); PG8_STAGE(PG8_SA(0, 1), cA + hstep, voffA);
        if (wr == 1) PG8_BAR;
        PG8_WAIT_V(2); PG8_BAR;
        PG8_STAGE(PG8_SB(1, 0), cB + kstep, voffB); PG8_STAGE(PG8_SA(1, 0), cA + kstep, voffA); PG8_STAGE(PG8_SB(1, 1), cB + hstep + kstep, voffB);
        PG8_WAIT_V(6); PG8_BAR;
    } else {
        PG8_STAGE(PG8_SB(0, 0), cB, voffB); PG8_STAGE(PG8_SA(0, 0), cA, voffA); PG8_STAGE(PG8_SB(0, 1), cB + hstep, voffB); PG8_STAGE(PG8_SA(0, 1), cA + hstep, voffA);
        if (wr == 1) PG8_BAR;
        PG8_WAIT_V(4); PG8_BAR;
        PG8_STAGE(PG8_SB(1, 0), cB + kstep, voffB); PG8_STAGE(PG8_SA(1, 0), cA + kstep, voffA); PG8_STAGE(PG8_SB(1, 1), cB + hstep + kstep, voffB);
        PG8_WAIT_V(6); PG8_BAR;
    }
    for (;;) {
        const bool has_next = S.next(ui + 1, nxt);
        const char* nA = has_next ? (const char*)g.A + (size_t)nxt.pm * tstep : cA; const char* nB = has_next ? (const char*)g.Bt + (size_t)nxt.pn * tstep : cB;
        for (int t = 0; t < nt; t += 2) {
            const bool last = (t == nt - 2);
            const char* a1 = cA + (size_t)(t + 1) * kstep;
            const char* a2 = last ? nA : cA + (size_t)(t + 2) * kstep; const char* b2 = last ? nB : cB + (size_t)(t + 2) * kstep;
            const char* a3 = a2 + kstep; const char* b3 = b2 + kstep;
            if (last && has_next) S.a_ready(nxt);
            if constexpr (SP2) {
            PG8_LDB(B0, 0, 0); PG8_LDB(B1, 0, 1); PG8_SCHED; PG8_LDA(At, 0, 0); PG8_STAGE(PG8_SA(1, 1), a1 + hstep, voffA);
            PG8_WAIT_V(8); PG8_WAIT_L(0); PG8_BAR; PG8_MMA(0, 0, At, B0); PG8_MMA(0, 1, At, B1); PG8_BAR; PG8_SCHED;
            PG8_LDA(At, 0, 1); PG8_STAGE(PG8_SB(0, 0), b2, voffB); PG8_STAGE(PG8_SB(0, 1), b2 + hstep, voffB); PG8_STAGE(PG8_SA(0, 0), a2, voffA);
            PG8_WAIT_V(8); PG8_WAIT_L(0); PG8_BAR; PG8_MMA(1, 0, At, B0); PG8_MMA(1, 1, At, B1); PG8_BAR; PG8_SCHED;
            PG8_LDB(B0, 1, 0); PG8_LDB(B1, 1, 1); PG8_SCHED; PG8_LDA(At, 1, 0); PG8_STAGE(PG8_SA(0, 1), a2 + hstep, voffA);
            PG8_WAIT_V(8); PG8_WAIT_L(0); PG8_BAR; PG8_MMA(0, 0, At, B0); PG8_MMA(0, 1, At, B1); PG8_BAR; PG8_SCHED;
            PG8_LDA(At, 1, 1); PG8_STAGE(PG8_SB(1, 0), b3, voffB); PG8_STAGE(PG8_SB(1, 1), b3 + hstep, voffB); PG8_STAGE(PG8_SA(1, 0), a3, voffA);
            PG8_WAIT_V(8); PG8_WAIT_L(0); PG8_BAR; PG8_MMA(1, 0, At, B0); PG8_MMA(1, 1, At, B1); PG8_BAR; PG8_SCHED;
            } else {
            PG8_LDB(B0, 0, 0); PG8_SCHED; PG8_LDA(At, 0, 0); PG8_STAGE(PG8_SA(1, 1), a1 + hstep, voffA);
            PG8_WAIT_L(8); PG8_BAR; PG8_WAIT_L(0); PG8_MMA(0, 0, At, B0); PG8_BAR; PG8_SCHED;
            PG8_LDB(B1, 0, 1); PG8_STAGE(PG8_SB(0, 0), b2, voffB);
            PG8_BAR; PG8_WAIT_L(0); PG8_MMA(0, 1, At, B1); PG8_BAR;
            PG8_LDA(At, 0, 1); PG8_STAGE(PG8_SA(0, 0), a2, voffA);
            PG8_BAR; PG8_WAIT_L(0); PG8_MMA(1, 0, At, B0); PG8_BAR; PG8_SCHED;
            PG8_STAGE(PG8_SB(0, 1), b2 + hstep, voffB);
            PG8_WAIT_V(6); PG8_BAR; PG8_MMA(1, 1, At, B1); PG8_BAR;
            PG8_LDB(B0, 1, 0); PG8_SCHED; PG8_LDA(At, 1, 0); PG8_STAGE(PG8_SA(0, 1), a2 + hstep, voffA);
            PG8_WAIT_L(8); PG8_BAR; PG8_WAIT_L(0); PG8_MMA(0, 0, At, B0); PG8_BAR; PG8_SCHED;
            PG8_LDB(B1, 1, 1); PG8_STAGE(PG8_SB(1, 0), b3, voffB);
            PG8_BAR; PG8_WAIT_L(0); PG8_MMA(0, 1, At, B1); PG8_BAR;
            PG8_LDA(At, 1, 1); PG8_STAGE(PG8_SA(1, 0), a3, voffA);
            PG8_BAR; PG8_WAIT_L(0); PG8_MMA(1, 0, At, B0); PG8_BAR; PG8_SCHED;
            PG8_STAGE(PG8_SB(1, 1), b3 + hstep, voffB);
            PG8_WAIT_V(6); PG8_BAR; PG8_MMA(1, 1, At, B1); PG8_BAR;
            }
        }
        if constexpr (ALIGN_EPI) { if (wr == 0) PG8_BAR; }
        if constexpr (!Epi::AFTER_DRAIN) { E(acc, cur, wr, wc, fr, fq); S.done(cur); }
        if (!has_next) break;
#pragma unroll
        for (int a = 0; a < 2; ++a)
#pragma unroll
            for (int b = 0; b < 2; ++b)
#pragma unroll
                for (int m = 0; m < 4; ++m)
#pragma unroll
                    for (int n = 0; n < 2; ++n) acc[a][b][m][n] = (f32x4){0.f, 0.f, 0.f, 0.f};
        cur = nxt; cA = nA; cB = nB; ++ui;
        if constexpr (ALIGN_EPI) { if (wr == 1) PG8_BAR; }
    }
    PG8_WAIT_V(0);
    if constexpr (!ALIGN_EPI) { if (wr == 0) PG8_BAR; }
    PG8_BAR;
    if constexpr (Epi::AFTER_DRAIN) { E.fused(acc, cur, wr, wc, fr, fq, lds, wid, lane); S.done(cur); }
#undef PG8_SA
#undef PG8_SB
#undef PG8_STAGE
#undef PG8_LDA
#undef PG8_LDB
#undef PG8_MMA
#undef PG8_WAIT_V
#undef PG8_WAIT_L
#undef PG8_BAR
#undef PG8_SCHED
}
}

#ifndef PG8_SP2
#define PG8_SP2 true
#endif
#ifndef PG8_ALIGN
#define PG8_ALIGN true
#endif
#include <hip/hip_bf16.h>
#include <cmath>
namespace attn_body {
using bf16=__hip_bfloat16;
using bf16x8=__attribute__((ext_vector_type(8)))short;
using s16x4=__attribute__((ext_vector_type(4)))short;
using f32x16=__attribute__((ext_vector_type(16)))float;
using u32x4=__attribute__((ext_vector_type(4)))unsigned;
constexpr int BATCH=8,NHEAD=16,SEQ=2048,D=64,DM=NHEAD*D;
constexpr int NW=8,QBLK=32,QB=QBLK*NW,KVBLK=64,NQB=SEQ/QB;
constexpr int ATTN_PITCH=DM, ATTN_UNIT_ROWS=QB;
__device__ __forceinline__ int crow(int r,int hi){return (r&3)+8*(r>>2)+4*hi;}
#define SBAR() __builtin_amdgcn_sched_barrier(0)
__device__ __forceinline__ void cmask(f32x16&p0,f32x16&p1,int jb,int qrel,int hi){
  const float NEG=-INFINITY; int kb=64*jb+4*hi;
  #pragma unroll
  for(int r=0;r<16;++r){int kv=kb+(r&3)+8*(r>>2); if(kv>qrel)p0[r]=NEG; if(kv+32>qrel)p1[r]=NEG;}
}

constexpr int NSLOT=3, SLOTB=8192;
constexpr int LDS_K=0, LDS_V=NSLOT*SLOTB, LDS_WS=2*NSLOT*SLOTB, LDS_OST=LDS_WS+NW*64*4, LDS_BYTES=LDS_OST+NW*4096;
constexpr float C2=0.125f*1.4426950408889634f;
__device__ __forceinline__ void glds16(const void*gsrc,unsigned lds_dst){unsigned keep;
  asm volatile("s_mov_b32 %0, m0\n\ts_mov_b32 m0, %2\n\ts_nop 0\n\tglobal_load_lds_dwordx4 %1, off\n\ts_mov_b32 m0, %0":"=&s"(keep):"v"(gsrc),"s"(lds_dst):"memory");}
__device__ __forceinline__ float max3f(float a,float b,float c){float r;asm("v_max3_f32 %0, %1, %2, %3":"=v"(r):"v"(a),"v"(b),"v"(c));return r;}
__device__ __forceinline__ float max2f(float a,float b){float r;asm("v_max_f32_e32 %0, %1, %2":"=v"(r):"v"(a),"v"(b));return r;}
__device__ __forceinline__ float fadd_s(float a,float b){float r;asm("v_add_f32_e32 %0, %1, %2":"=v"(r):"v"(a),"v"(b));return r;}
__device__ __forceinline__ float fsub_s(float a,float b){float r;asm("v_sub_f32_e32 %0, %1, %2":"=v"(r):"v"(a),"v"(b));return r;}
typedef float f32x2_t __attribute__((ext_vector_type(2))); typedef __bf16 bf16x2_t __attribute__((ext_vector_type(2)));
__device__ __forceinline__ unsigned cvtpk_s(float lo,float hi){f32x2_t v={lo,hi};bf16x2_t b=__builtin_convertvector(v,bf16x2_t);return __builtin_bit_cast(unsigned,b);}
#define WAIT_BAR(N) asm volatile("s_waitcnt vmcnt(" #N ") lgkmcnt(0)\n\ts_barrier":::"memory")

__device__ __forceinline__ void qkt(f32x16&p0,f32x16&p1,const char*Kslot,const bf16x8*qr,const f32x16&negm,int r32,int hi){
  const char*kb=Kslot+hi*1024+r32*16;
  #pragma unroll
  for(int d0=0;d0<4;++d0){
    const bf16x8 b0=*reinterpret_cast<const bf16x8*>(kb+d0*2048);
    const bf16x8 b1=*reinterpret_cast<const bf16x8*>(kb+d0*2048+512);
    if(d0==0){p0=__builtin_amdgcn_mfma_f32_32x32x16_bf16(b0,qr[0],negm,0,0,0);p1=__builtin_amdgcn_mfma_f32_32x32x16_bf16(b1,qr[0],negm,0,0,0);}
    else{p0=__builtin_amdgcn_mfma_f32_32x32x16_bf16(b0,qr[d0],p0,0,0,0);p1=__builtin_amdgcn_mfma_f32_32x32x16_bf16(b1,qr[d0],p1,0,0,0);}}
}
typedef __attribute__((address_space(3))) const char* lds_cptr;
typedef short v4i16_t __attribute__((ext_vector_type(4)));
__device__ __forceinline__ void kload8(bf16x8*kf,lds_cptr kp){
  kf[0]=*(const __attribute__((address_space(3))) bf16x8*)(kp);      kf[1]=*(const __attribute__((address_space(3))) bf16x8*)(kp+512);
  kf[2]=*(const __attribute__((address_space(3))) bf16x8*)(kp+2048); kf[3]=*(const __attribute__((address_space(3))) bf16x8*)(kp+2560);
  kf[4]=*(const __attribute__((address_space(3))) bf16x8*)(kp+4096); kf[5]=*(const __attribute__((address_space(3))) bf16x8*)(kp+4608);
  kf[6]=*(const __attribute__((address_space(3))) bf16x8*)(kp+6144); kf[7]=*(const __attribute__((address_space(3))) bf16x8*)(kp+6656);
}
__device__ __forceinline__ void kload2(bf16x8*kf,lds_cptr kp,int j){ kf[2*j]=*(const __attribute__((address_space(3))) bf16x8*)(kp+j*2048); kf[2*j+1]=*(const __attribute__((address_space(3))) bf16x8*)(kp+j*2048+512); }
__device__ __forceinline__ s16x4 vtr(lds_cptr p){ return __builtin_bit_cast(s16x4,__builtin_amdgcn_ds_read_tr16_b64_v4i16((__attribute__((address_space(3))) v4i16_t*)p)); }
__device__ __forceinline__ float rowmax(const f32x16&p0,const f32x16&p1){
  float a=max3f(p0[0],p0[1],p1[0]),b=max3f(p0[2],p0[3],p1[1]);a=max3f(a,p1[2],p1[3]);
  #pragma unroll
  for(int r=4;r<16;r+=4){a=max3f(a,p0[r],p0[r+1]);b=max3f(b,p0[r+2],p0[r+3]);a=max3f(a,p1[r],p1[r+1]);b=max3f(b,p1[r+2],p1[r+3]);}
  const float m=max2f(a,b);
  auto rr=__builtin_amdgcn_permlane32_swap(__float_as_uint(m),__float_as_uint(m),false,false);
  return max2f(__uint_as_float(rr[0]),__uint_as_float(rr[1]));
}
__device__ __forceinline__ void pv(f32x16*o,int vb,bf16x8 pa0,bf16x8 pa1,bf16x8 pa2,bf16x8 pa3){
  #pragma unroll
  for(int d0=0;d0<2;++d0){s16x4 lo[4],hi[4];
    #pragma unroll
    for(int ks=0;ks<4;++ks){
      asm volatile("ds_read_b64_tr_b16 %0,%1 offset:%c2":"=&v"(lo[ks]):"v"(vb),"i"(d0*4096+ks*1024):"memory");
      asm volatile("ds_read_b64_tr_b16 %0,%1 offset:%c2":"=&v"(hi[ks]):"v"(vb),"i"(d0*4096+ks*1024+512):"memory");}
    asm volatile("s_waitcnt lgkmcnt(0)":::"memory");SBAR();
    #define PK(k) (bf16x8){lo[k][0],lo[k][1],lo[k][2],lo[k][3],hi[k][0],hi[k][1],hi[k][2],hi[k][3]}
    o[d0]=__builtin_amdgcn_mfma_f32_32x32x16_bf16(pa0,PK(0),o[d0],0,0,0);
    o[d0]=__builtin_amdgcn_mfma_f32_32x32x16_bf16(pa1,PK(1),o[d0],0,0,0);
    o[d0]=__builtin_amdgcn_mfma_f32_32x32x16_bf16(pa2,PK(2),o[d0],0,0,0);
    o[d0]=__builtin_amdgcn_mfma_f32_32x32x16_bf16(pa3,PK(3),o[d0],0,0,0);
    #undef PK
  }
}

#ifndef ATTN_STORE16
#define ATTN_STORE16(p,v) (*(u32x4*)(p)=(v))
#endif
template<int THRL> __device__ __forceinline__ void attn_unit(int b,int h,int hv,int qb,const bf16*Q,const bf16*__restrict__ K,const bf16*__restrict__ V,bf16*O,char*shm){
  int tid_=threadIdx.x; asm volatile("":"+v"(tid_)); const int tid=tid_,lane=tid&63,r32=lane&31,hi=lane>>5; const int wid=__builtin_amdgcn_readfirstlane(tid>>6);
  const long rowbase=(long)b*SEQ; const int q0=qb*QB;
  const bf16*Qw=Q+(rowbase+q0+wid*QBLK)*DM+h*D;
  const bf16*Kh=K+rowbase*DM+h*D,*Vh=V+rowbase*DM+hv*D;
  const unsigned lds0=(unsigned)(uintptr_t)shm;
  float*wsf=(float*)(shm+LDS_WS)+wid*64;
  const bf16*ksrc=Kh+(long)lane*DM+wid*8;
  const bf16*vsrc=Vh+(long)(16*(wid&3)+(lane>>2))*DM+(wid>>2)*32+(lane&3)*8;
  const unsigned kdst=lds0+LDS_K+wid*1024, vdst=lds0+LDS_V+wid*1024;
  #define DMA_K(t,slot) glds16(ksrc+(long)(t)*KVBLK*DM,(unsigned)__builtin_amdgcn_readfirstlane(kdst+(slot)))
  #define DMA_V(t,slot) glds16(vsrc+(long)(t)*KVBLK*DM,(unsigned)__builtin_amdgcn_readfirstlane(vdst+(slot)))
  const int vb0=(int)(lds0+LDS_V)+((lane>>4)&1)*32+(lane&3)*8+(4*hi+((lane&15)>>2))*64;
  const char*Kbase=shm+LDS_K; bf16x8 kf[8];
  const lds_cptr shm3=(lds_cptr)shm; const lds_cptr kp0=shm3+LDS_K+hi*1024+r32*16; const lds_cptr vp0=shm3+LDS_V+((lane>>4)&1)*32+(lane&3)*8+(4*hi+((lane&15)>>2))*64;
  const int NT=(q0+QB)/KVBLK;
  DMA_K(0,0);DMA_V(0,0);DMA_K(1,SLOTB);
  bf16x8 qr[4];
  #pragma unroll
  for(int d0=0;d0<4;++d0)qr[d0]=*reinterpret_cast<const bf16x8*>(&Qw[(long)r32*DM+d0*16+hi*8]);
  float mhat=0.f,l_reg=0.f;f32x16 o[2];o[0]=f32x16{};o[1]=f32x16{};f32x16 negm=f32x16{};asm volatile("":"+v"(negm));
  const int qrel=wid*QBLK+r32;
  #define CMASK(P0,P1,t) do{int jb_=(t)-(NT-4); if(jb_>=0)cmask(P0,P1,jb_,qrel,hi);}while(0)
  bool resc=false;
  #define START(P0,P1) do{ const float rm=rowmax(P0,P1); resc=false; \
    { const float dl=rm; mhat=fadd_s(mhat,dl); \
      _Pragma("unroll") for(int r=0;r<16;++r){P0[r]=fsub_s(P0[r],dl);P1[r]=fsub_s(P1[r],dl);} \
      _Pragma("unroll") for(int r=0;r<16;++r)negm[r]=-mhat; asm volatile("":"+v"(negm)); } \
    _Pragma("unroll") for(int r=0;r<16;++r)P0[r]=__builtin_amdgcn_exp2f(P0[r]); }while(0)
  #define RESC() do{ if(resc){ asm volatile("s_waitcnt lgkmcnt(0)":::"memory"); \
      _Pragma("unroll") for(int d_=0;d_<2;++d_) _Pragma("unroll") for(int r=0;r<16;++r)o[d_][r]*=wsf[crow(r,hi)]; } }while(0)
  f32x16 pA0,pA1,pB0,pB1;
  int sl_prev=0,sl_cur=0,sl_next=SLOTB;
  #define ROT() do{sl_prev=sl_cur;sl_cur=sl_next;sl_next=(sl_next==(NSLOT-1)*SLOTB)?0:sl_next+SLOTB;}while(0)
  DMA_K(2,2*SLOTB);
  WAIT_BAR(3);
  qkt(pA0,pA1,Kbase,qr,negm,r32,hi);asm volatile("s_nop 15\n\ts_nop 7":"+v"(pA0),"+v"(pA1));CMASK(pA0,pA1,0);
  START(pA0,pA1);
  _Pragma("unroll") for(int r=0;r<16;++r)pA1[r]=__builtin_amdgcn_exp2f(pA1[r]);
  WAIT_BAR(0);
  DMA_K(3,0);DMA_V(1,SLOTB);
  ROT();
  kload8(kf,kp0+sl_cur);
  WAIT_BAR(2);
  s16x4 vlo[8],vhi[8]; u32x4 pw0,pw1,pw2,pw3;
  #define PKW(P,B) cvtpk_s(P[B],P[B+1])
  #define PAF(k) __builtin_bit_cast(bf16x8,pw##k)
  #define VFR(i) (bf16x8){vlo[i][0],vlo[i][1],vlo[i][2],vlo[i][3],vhi[i][0],vhi[i][1],vhi[i][2],vhi[i][3]}
  #define PIN(x) asm volatile("":"+v"(x))
  #define MX3(a,b,c) __builtin_fmaxf(__builtin_fmaxf((a),(b)),(c))
  #define GAPA(MF,A0,A1,A2,A3,W0,W1,PW) do{ MF; sacc+=A0; sacc+=A1; sacc+=A2; sacc+=A3; PIN(sacc); W0; W1; PIN(PW); SBAR(); }while(0)
  #define EX(v) __builtin_amdgcn_exp2f(v)
  #define GAPB(MF,X,B) do{ MF; X[B]=EX(X[B]); X[B+1]=EX(X[B+1]); X[B+2]=EX(X[B+2]); X[B+3]=EX(X[B+3]); PIN(X); SBAR(); }while(0)
  #define VRD(i) do{ vlo[i]=vtr(vp_+(((i)>>2)*4096+((i)&3)*1024)); vhi[i]=vtr(vp_+(((i)>>2)*4096+((i)&3)*1024+512)); }while(0)
  #define KRD(G,j) do{ if(G){ kload2(kf,kp0+sl_next,j); SBAR(); } }while(0)
  #define STEP(C0,C1,P0,P1,t,GK,GV,GL) do{ SBAR(); \
    const lds_cptr vp_=vp0+sl_prev; \
    VRD(0); SBAR(); float sacc=(P0[0]+P0[1]); \
    GAPA(C0=__builtin_amdgcn_mfma_f32_32x32x16_bf16(kf[0],qr[0],negm,0,0,0), P0[2],P0[3],P0[4],P0[5],     pw0[0]=PKW(P0,0), pw0[1]=PKW(P0,2), pw0); \
    VRD(4); SBAR(); GAPA(C1=__builtin_amdgcn_mfma_f32_32x32x16_bf16(kf[1],qr[0],negm,0,0,0), P0[6],P0[7],P0[8],P0[9],     pw0[2]=PKW(P0,4), pw0[3]=PKW(P0,6), pw0); \
    VRD(1); SBAR(); GAPA(C0=__builtin_amdgcn_mfma_f32_32x32x16_bf16(kf[2],qr[1],C0,0,0,0),   P0[10],P0[11],P0[12],P0[13], pw1[0]=PKW(P0,8), pw1[1]=PKW(P0,10), pw1); \
    VRD(5); SBAR(); GAPA(C1=__builtin_amdgcn_mfma_f32_32x32x16_bf16(kf[3],qr[1],C1,0,0,0),   P0[14],P0[15],P1[0],P1[1],   pw1[2]=PKW(P0,12),pw1[3]=PKW(P0,14), pw1); \
    VRD(2); SBAR(); GAPA(C0=__builtin_amdgcn_mfma_f32_32x32x16_bf16(kf[4],qr[2],C0,0,0,0),   P1[2],P1[3],P1[4],P1[5],     pw2[0]=PKW(P1,0), pw2[1]=PKW(P1,2), pw2); \
    VRD(6); SBAR(); GAPA(C1=__builtin_amdgcn_mfma_f32_32x32x16_bf16(kf[5],qr[2],C1,0,0,0),   P1[6],P1[7],P1[8],P1[9],     pw2[2]=PKW(P1,4), pw2[3]=PKW(P1,6), pw2); \
    VRD(3); SBAR(); GAPA(C0=__builtin_amdgcn_mfma_f32_32x32x16_bf16(kf[6],qr[3],C0,0,0,0),   P1[10],P1[11],P1[12],P1[13], pw3[0]=PKW(P1,8), pw3[1]=PKW(P1,10), pw3); \
    VRD(7); SBAR(); GAPA(C1=__builtin_amdgcn_mfma_f32_32x32x16_bf16(kf[7],qr[3],C1,0,0,0),   P1[14],P1[15],0.f,0.f,       pw3[2]=PKW(P1,12),pw3[3]=PKW(P1,14), pw3); \
    l_reg+=sacc; \
    if(GK){DMA_K((t)+3,sl_cur);} if(GV){DMA_V((t)+1,sl_next);} \
    CMASK(C0,C1,t); \
    { float a=MX3(C0[0],C0[1],C1[0]),b=MX3(C0[2],C0[3],C1[1]); a=MX3(a,C1[2],C1[3]); \
      _Pragma("unroll") for(int r=4;r<16;r+=4){a=MX3(a,C0[r],C0[r+1]);b=MX3(b,C0[r+2],C0[r+3]);a=MX3(a,C1[r],C1[r+1]);b=MX3(b,C1[r+2],C1[r+3]);} \
      float rm=__builtin_fmaxf(a,b); { auto rr=__builtin_amdgcn_permlane32_swap(__float_as_uint(rm),__float_as_uint(rm),false,false); rm=__builtin_fmaxf(__uint_as_float(rr[0]),__uint_as_float(rr[1])); } \
      resc=false; \
      if(__builtin_expect(__any(rm>(float)THRL),0)){ const float dl=__builtin_fmaxf(rm,0.f); mhat+=dl; \
        _Pragma("unroll") for(int r=0;r<16;++r){C0[r]-=dl;C1[r]-=dl;} \
        _Pragma("unroll") for(int r=0;r<16;++r)negm[r]=-mhat; asm volatile("":"+v"(negm)); \
        const float f=__builtin_amdgcn_exp2f(-dl); l_reg*=f; if(hi==0)wsf[r32]=f; resc=true; } } \
    SBAR(); \
    GAPB(o[0]=__builtin_amdgcn_mfma_f32_32x32x16_bf16(PAF(0),VFR(0),o[0],0,0,0), C0,0); \
    GAPB(o[1]=__builtin_amdgcn_mfma_f32_32x32x16_bf16(PAF(0),VFR(4),o[1],0,0,0), C0,4); \
    KRD(GL,0); GAPB(o[0]=__builtin_amdgcn_mfma_f32_32x32x16_bf16(PAF(1),VFR(1),o[0],0,0,0), C0,8); \
    KRD(GL,1); GAPB(o[1]=__builtin_amdgcn_mfma_f32_32x32x16_bf16(PAF(1),VFR(5),o[1],0,0,0), C0,12); \
    KRD(GL,2); GAPB(o[0]=__builtin_amdgcn_mfma_f32_32x32x16_bf16(PAF(2),VFR(2),o[0],0,0,0), C1,0); \
    KRD(GL,3); GAPB(o[1]=__builtin_amdgcn_mfma_f32_32x32x16_bf16(PAF(2),VFR(6),o[1],0,0,0), C1,4); \
    GAPB(o[0]=__builtin_amdgcn_mfma_f32_32x32x16_bf16(PAF(3),VFR(3),o[0],0,0,0), C1,8); \
    GAPB(o[1]=__builtin_amdgcn_mfma_f32_32x32x16_bf16(PAF(3),VFR(7),o[1],0,0,0), C1,12); \
    }while(0)
  int t=1;
  #undef CMASK
  #define CMASK(P0,P1,t) do{}while(0)
  for(;t+5<NT;t+=2){
    STEP(pB0,pB1,pA0,pA1,t,true,true,true);     WAIT_BAR(2); RESC(); ROT();
    STEP(pA0,pA1,pB0,pB1,t+1,true,true,true);   WAIT_BAR(2); RESC(); ROT();
  }
  #undef CMASK
  #define CMASK(P0,P1,t) do{int jb_=(t)-(NT-4); if(jb_>=0)cmask(P0,P1,jb_,qrel,hi);}while(0)
  #define ENDW(tt) do{ if((tt)+3<NT){WAIT_BAR(2);} else if((tt)+2<NT){WAIT_BAR(1);} else {WAIT_BAR(0);} }while(0)
  for(;t+1<NT;t+=2){
    STEP(pB0,pB1,pA0,pA1,t,(t+3<NT),(t+1<NT),(t+1<NT));       ENDW(t);   RESC(); ROT();
    STEP(pA0,pA1,pB0,pB1,t+1,(t+4<NT),(t+2<NT),(t+2<NT));     ENDW(t+1); RESC(); ROT();
  }
  STEP(pB0,pB1,pA0,pA1,NT-1,false,false,false); RESC();
  { float sacc=pB0[0]+pB0[1]; _Pragma("unroll") for(int r=2;r<16;++r)sacc+=pB0[r]; _Pragma("unroll") for(int r=0;r<16;++r)sacc+=pB1[r]; l_reg+=sacc;
    pw0=(u32x4){PKW(pB0,0),PKW(pB0,2),PKW(pB0,4),PKW(pB0,6)};pw1=(u32x4){PKW(pB0,8),PKW(pB0,10),PKW(pB0,12),PKW(pB0,14)};pw2=(u32x4){PKW(pB1,0),PKW(pB1,2),PKW(pB1,4),PKW(pB1,6)};pw3=(u32x4){PKW(pB1,8),PKW(pB1,10),PKW(pB1,12),PKW(pB1,14)};
    SBAR(); pv(o,vb0+sl_cur,PAF(0),PAF(1),PAF(2),PAF(3)); }
  #undef PKW
  #undef PAF
  #undef VFR
  #undef PIN
  #undef MX3
  #undef GAPA
  #undef GAPB
  #undef EX
  #undef VRD
  #undef KRD
  #undef STEP
  #undef ENDW
  {auto rr=__builtin_amdgcn_permlane32_swap(__float_as_uint(l_reg),__float_as_uint(l_reg),false,false);l_reg=__uint_as_float(rr[0])+__uint_as_float(rr[1]);}
  if(hi==0)wsf[32+r32]=l_reg;asm volatile("s_waitcnt lgkmcnt(0)":::"memory");
  float rli[16];
  #pragma unroll
  for(int r=0;r<16;++r)rli[r]=__builtin_amdgcn_rcpf(wsf[32+crow(r,hi)]);
  bf16*Ow=O+(rowbase+q0+wid*QBLK)*DM+hv*D;
  { bf16*stg=(bf16*)(shm+LDS_OST)+wid*2048;
    #pragma unroll
    for(int r=0;r<16;++r){const int orow=crow(r,hi);
      #pragma unroll
      for(int d0=0;d0<2;++d0)stg[orow*64+d0*32+r32]=__float2bfloat16(o[d0][r]*rli[r]);}
    asm volatile("s_waitcnt lgkmcnt(0)":::"memory");
    #pragma unroll
    for(int i=0;i<4;++i){const int row=i*8+(lane>>3),ch=lane&7; const u32x4 v=*(const u32x4*)(stg+row*64+ch*8); ATTN_STORE16(Ow+(long)row*DM+ch*8,v);} }
  asm volatile("s_waitcnt lgkmcnt(0)\n\ts_barrier":::"memory");
  #undef DMA_K
  #undef DMA_V
  #undef CMASK
  #undef START
  #undef RESC
  #undef ROT
}
constexpr int ATTN_LDS_BYTES=LDS_BYTES;
#undef SBAR
#undef WAIT_BAR
}
#include <hip/hip_cooperative_groups.h>
namespace cg = cooperative_groups;
#define LAS __attribute__((address_space(3)))
typedef unsigned short bf16;
typedef unsigned v4u __attribute__((ext_vector_type(4)));
typedef unsigned v2u __attribute__((ext_vector_type(2)));
typedef float f32x4 __attribute__((ext_vector_type(4)));
typedef short bf16x8 __attribute__((ext_vector_type(8)));

constexpr int M = 16384, DM = 2048, DFF = 5632, SEQ = 2048, NB = 8;
constexpr int NPROJ = 7168;
constexpr float EPS = 1e-6f;
constexpr float LOG2E = 1.4426950408889634f;
constexpr size_t MiB = 1u << 20;
constexpr size_t WS_ROPE = 0;
constexpr size_t WS_BAR = 256 * 1024, WS_BAR_BYTES = 16384;
constexpr size_t WS_SS = 320 * 1024;
constexpr size_t WS_CNT = 576 * 1024;
constexpr size_t WS_ZERO_BYTES = 336 * 1024;
constexpr size_t WS_WFI = 1 * MiB;
constexpr size_t WS_WFO = 45 * MiB;
constexpr size_t WS_WIN = 67 * MiB;
constexpr size_t WS_WPA = 111 * MiB, WS_WPR = 115 * MiB, WS_WWO = 119 * MiB;
constexpr size_t WS_H = 127 * MiB;
constexpr size_t WS_BIG = 191 * MiB;
constexpr size_t WS_Y = 415 * MiB;
constexpr size_t WS_OR = 479 * MiB;
constexpr size_t WS_END = 511 * MiB;
constexpr size_t PBUF = (size_t)M * 1024;
enum { PB_QA = 0, PB_KA = 1, PB_VA = 2, PB_QR = 3, PB_LF = 4, PB_IO = 5, PB_G = 6 };
constexpr int RING_BYTES = 131072, LDS_BYTES = 147456;

__device__ __forceinline__ float fexp(float x) { return __builtin_amdgcn_exp2f(x * LOG2E); }
__device__ __forceinline__ float sigm(float x) { return __builtin_amdgcn_rcpf(1.f + fexp(-x)); }
__device__ __forceinline__ float silu(float x) { return x * sigm(x); }
typedef float f32x2_m __attribute__((ext_vector_type(2))); typedef __bf16 bf16x2_m __attribute__((ext_vector_type(2)));
__device__ __forceinline__ unsigned pkbf(float lo, float hi) { const f32x2_m v = {lo, hi}; const bf16x2_m b = __builtin_convertvector(v, bf16x2_m); return __builtin_bit_cast(unsigned, b); }
__device__ __forceinline__ float bflo(unsigned w) { return __builtin_bit_cast(float, w << 16); }
__device__ __forceinline__ float bfhi(unsigned w) { return __builtin_bit_cast(float, w & 0xffff0000u); }
__device__ __forceinline__ unsigned pkh(float lo, float hi) { const _Float16 a = (_Float16)lo, b = (_Float16)hi; return (unsigned)__builtin_bit_cast(unsigned short, a) | ((unsigned)__builtin_bit_cast(unsigned short, b) << 16); }
__device__ __forceinline__ float wave_sum(float v) {
#pragma unroll
    for (int o = 1; o < 64; o <<= 1) v += __shfl_xor(v, o);
    return v;
}

namespace epi {
using pg8::Unit; using pg8::BM; using pg8::HALF;
template <int RSM> __device__ __forceinline__ float row_scale(const float* p, int row) { const float v = __hip_atomic_load(p + row, __ATOMIC_RELAXED, __HIP_MEMORY_SCOPE_AGENT); return RSM == 0 ? v : 1.0f / sqrtf(v * (1.f / DM) + EPS); }
template <int RSM> struct EpiSwiglu { static constexpr bool PERM = true, AFTER_DRAIN = false; bf16* O; int ldc; const float* rs;
    __device__ __forceinline__ void operator()(const f32x4 (&acc)[2][2][4][2], const Unit& u, int wr, int wc, int fr, int fq) const {
        const int row0 = u.pm * BM + wr * 64 + fr, col0 = u.pn * HALF + wc * 32 + 8 * fq;
#pragma unroll
        for (int ai = 0; ai < 2; ++ai)
#pragma unroll
            for (int m = 0; m < 4; ++m) { const int row = row0 + ai * HALF + m * 16; bf16* rowp = O + (size_t)row * ldc + col0; const float sc = row_scale<RSM>(rs, row);
                const f32x4 g0 = acc[ai][0][m][0] * sc, g1 = acc[ai][0][m][1] * sc, u0 = acc[ai][1][m][0] * sc, u1 = acc[ai][1][m][1] * sc;
                v4u w; w.x = pkbf(silu(g0[0]) * u0[0], silu(g0[1]) * u0[1]); w.y = pkbf(silu(g0[2]) * u0[2], silu(g0[3]) * u0[3]);
                w.z = pkbf(silu(g1[0]) * u1[0], silu(g1[1]) * u1[1]); w.w = pkbf(silu(g1[2]) * u1[2], silu(g1[3]) * u1[3]);
                *(v4u*)rowp = w; }
    }
};
template <int NORM, int SSI, bool HALFSC> struct EpiResid { static constexpr bool PERM = false, AFTER_DRAIN = false; static constexpr int ldc = DM; const float* base; float* out; unsigned char* wsb;
    __device__ __forceinline__ void operator()(const f32x4 (&acc)[2][2][4][2], const Unit& u, int wr, int wc, int fr, int fq) const {
        const int row0 = u.pm * BM + wr * 64 + fr, col0 = u.pn * BM + wc * 32 + 4 * fq; const float scale = HALFSC ? 0.5f : 1.0f;
        bf16* xb = (bf16*)(wsb + WS_H); float* ss = (float*)(wsb + WS_SS) + (size_t)SSI * M;
#pragma unroll
        for (int ai = 0; ai < 2; ++ai) { f32x4 pre[4][2][2];
#pragma unroll
            for (int m = 0; m < 4; ++m)
#pragma unroll
                for (int bj = 0; bj < 2; ++bj)
#pragma unroll
                    for (int n = 0; n < 2; ++n) pre[m][bj][n] = *(const f32x4*)(base + (size_t)(row0 + ai * HALF + m * 16) * ldc + col0 + bj * HALF + n * 16);
            asm volatile("" ::: "memory");
#pragma unroll
            for (int m = 0; m < 4; ++m) { const int row = row0 + ai * HALF + m * 16; const size_t off = (size_t)row * ldc + col0; float sq = 0.f;
#pragma unroll
                for (int bj = 0; bj < 2; ++bj)
#pragma unroll
                    for (int n = 0; n < 2; ++n) { const size_t p = off + bj * HALF + n * 16; const f32x4 o = pre[m][bj][n] + acc[ai][bj][m][n] * scale; *(f32x4*)(out + p) = o;
                        if (NORM == 1) *(v2u*)(xb + p) = (v2u){pkbf(o[0], o[1]), pkbf(o[2], o[3])};
                        if (NORM) sq += (o[0] * o[0] + o[1] * o[1]) + (o[2] * o[2] + o[3] * o[3]); }
                if (NORM) { sq += __shfl_xor(sq, 16); sq += __shfl_xor(sq, 32); if (fq == 0) __hip_atomic_fetch_add(ss + row, sq, __ATOMIC_RELAXED, __HIP_MEMORY_SCOPE_AGENT); } } }
    }
};
template <int MODE> struct EpiGate { static constexpr bool PERM = true, AFTER_DRAIN = false; bf16* T1; const unsigned char* gt;
    __device__ __forceinline__ void operator()(const f32x4 (&acc)[2][2][4][2], const Unit& u, int wr, int wc, int fr, int fq) const {
        const int row0 = u.pm * BM + wr * 64 + fr, col0 = u.pn * BM + wc * 32 + 8 * fq;
#pragma unroll
        for (int ai = 0; ai < 2; ++ai) { v2u gq[4][2]; v4u tq[4][2];
#pragma unroll
            for (int m = 0; m < 4; ++m)
#pragma unroll
                for (int bj = 0; bj < 2; ++bj) { const size_t p = (size_t)(row0 + ai * HALF + m * 16) * DM + col0 + bj * HALF; gq[m][bj] = *(const v2u*)(gt + p); if (MODE == 1) tq[m][bj] = *(const v4u*)(T1 + p); }
            asm volatile("" ::: "memory");
#pragma unroll
            for (int m = 0; m < 4; ++m)
#pragma unroll
                for (int bj = 0; bj < 2; ++bj) { const size_t p = (size_t)(row0 + ai * HALF + m * 16) * DM + col0 + bj * HALF;
                    const f32x4 a0 = acc[ai][bj][m][0], a1 = acc[ai][bj][m][1]; const v2u g = gq[m][bj]; const float s = 1.f / 255.f;
                    float v[8] = {a0[0] * ((float)((g.x >> 0) & 0xffu) * s), a0[1] * ((float)((g.x >> 8) & 0xffu) * s), a0[2] * ((float)((g.x >> 16) & 0xffu) * s), a0[3] * ((float)((g.x >> 24) & 0xffu) * s),
                                  a1[0] * ((float)((g.y >> 0) & 0xffu) * s), a1[1] * ((float)((g.y >> 8) & 0xffu) * s), a1[2] * ((float)((g.y >> 16) & 0xffu) * s), a1[3] * ((float)((g.y >> 24) & 0xffu) * s)};
                    if (MODE == 1) { const v4u t = tq[m][bj];
                        v[0] += bflo(t.x); v[1] += bfhi(t.x); v[2] += bflo(t.y); v[3] += bfhi(t.y); v[4] += bflo(t.z); v[5] += bfhi(t.z); v[6] += bflo(t.w); v[7] += bfhi(t.w); }
                    v4u w; w.x = pkbf(v[0], v[1]); w.y = pkbf(v[2], v[3]); w.z = pkbf(v[4], v[5]); w.w = pkbf(v[6], v[7]);
                    *(v4u*)(T1 + p) = w; } }
    }
};
struct EpiMix { static constexpr bool PERM = true, AFTER_DRAIN = false; unsigned char* wsb; const float* lbraw;
    __device__ __forceinline__ void operator()(const f32x4 (&acc)[2][2][4][2], const Unit& u, int wr, int wc, int fr, int fq) const {
        bf16* P = (bf16*)(wsb + WS_BIG); const float* ropeC = (const float*)(wsb + WS_ROPE); const float* ropeS = ropeC + SEQ * 8; const float* rs = (const float*)(wsb + WS_SS) + M;
        const int reg = u.pn >> 2; bf16* base = P + (size_t)reg * PBUF;
        const int row0 = u.pm * BM + wr * 64 + fr, lc0 = (u.pn & 3) * 256 + wc * 32 + 8 * fq;
        const bool rope = (reg <= 1) && ((wc & 1) == 0);
        const float qs = (reg == 0) ? attn_body::C2 : 1.f;
        float lb[2][8];
        if (reg == PB_LF) {
#pragma unroll
            for (int bj = 0; bj < 2; ++bj)
#pragma unroll
                for (int j = 0; j < 8; ++j) { const int c = lc0 + bj * HALF + j; lb[bj][j] = sigm(lbraw[c] - lbraw[1024 + c]); }
        }
#pragma unroll
        for (int ai = 0; ai < 2; ++ai)
#pragma unroll
            for (int m = 0; m < 4; ++m) { const int row = row0 + ai * HALF + m * 16; const float sc = row_scale<1>(rs, row);
                f32x4 c0, c1, s0, s1;
                if (rope) { const int pos = row & (SEQ - 1); c0 = *(const f32x4*)(ropeC + pos * 8); c1 = *(const f32x4*)(ropeC + pos * 8 + 4); s0 = *(const f32x4*)(ropeS + pos * 8); s1 = *(const f32x4*)(ropeS + pos * 8 + 4); }
#pragma unroll
                for (int bj = 0; bj < 2; ++bj) { const f32x4 a0 = acc[ai][bj][m][0] * sc, a1 = acc[ai][bj][m][1] * sc;
                    float v[8] = {a0[0], a0[1], a0[2], a0[3], a1[0], a1[1], a1[2], a1[3]};
                    v4u w;
                    if (reg >= 7) {
                        unsigned g0 = 0u, g1 = 0u;
                        g0 = __builtin_amdgcn_cvt_pk_u8_f32(__builtin_rintf(sigm(v[0]) * 255.f), 0, g0); g0 = __builtin_amdgcn_cvt_pk_u8_f32(__builtin_rintf(sigm(v[1]) * 255.f), 1, g0);
                        g0 = __builtin_amdgcn_cvt_pk_u8_f32(__builtin_rintf(sigm(v[2]) * 255.f), 2, g0); g0 = __builtin_amdgcn_cvt_pk_u8_f32(__builtin_rintf(sigm(v[3]) * 255.f), 3, g0);
                        g1 = __builtin_amdgcn_cvt_pk_u8_f32(__builtin_rintf(sigm(v[4]) * 255.f), 0, g1); g1 = __builtin_amdgcn_cvt_pk_u8_f32(__builtin_rintf(sigm(v[5]) * 255.f), 1, g1);
                        g1 = __builtin_amdgcn_cvt_pk_u8_f32(__builtin_rintf(sigm(v[6]) * 255.f), 2, g1); g1 = __builtin_amdgcn_cvt_pk_u8_f32(__builtin_rintf(sigm(v[7]) * 255.f), 3, g1);
                        unsigned char* gb = wsb + WS_WFI + (reg >= 9 ? (size_t)M * DM : (size_t)0);
                        *(v2u*)(gb + (size_t)row * DM + ((u.pn - 28) & 7) * 256 + wc * 32 + 8 * fq + bj * HALF) = (v2u){g0, g1};
                        continue; }
                    if (reg <= 1) {
                        if (rope) { const float cs[8] = {c0[0], c0[1], c0[2], c0[3], c1[0], c1[1], c1[2], c1[3]}; const float sn[8] = {s0[0], s0[1], s0[2], s0[3], s1[0], s1[1], s1[2], s1[3]};
#pragma unroll
                            for (int j = 0; j < 8; ++j) { const float o = __shfl_xor(v[j], 16); if (fq == 0) v[j] = v[j] * cs[j] - o * sn[j]; else if (fq == 1) v[j] = v[j] * cs[j] + o * sn[j]; } }
#pragma unroll
                        for (int j = 0; j < 8; ++j) v[j] *= qs;
                    } else if (reg == PB_QR || reg == PB_G) {
#pragma unroll
                        for (int j = 0; j < 8; ++j) v[j] = silu(v[j]);
                    }
                    if (reg == PB_LF) {
#pragma unroll
                        for (int j = 0; j < 8; ++j) v[j] = (1.f - lb[bj][j]) * sigm(-v[j]);
                        w.x = pkh(v[0], v[1]); w.y = pkh(v[2], v[3]); w.z = pkh(v[4], v[5]); w.w = pkh(v[6], v[7]);
                    } else { w.x = pkbf(v[0], v[1]); w.y = pkbf(v[2], v[3]); w.z = pkbf(v[4], v[5]); w.w = pkbf(v[6], v[7]); }
                    *(v4u*)(base + (size_t)row * 1024 + lc0 + bj * HALF) = w; } }
    }
};
struct EpiFinal { static constexpr bool PERM = false, AFTER_DRAIN = false; static constexpr int ldc = DM; float* out; unsigned char* wsb; const float* wfin;
    __device__ __forceinline__ void operator()(f32x4 (&acc)[2][2][4][2], const Unit& u, int wr, int wc, int fr, int fq) const {
        const int row0 = u.pm * BM + wr * 64 + fr, col0 = u.pn * BM + wc * 32 + 4 * fq;
        float* ss = (float*)(wsb + WS_SS) + (size_t)3 * M; unsigned* cnt = (unsigned*)(wsb + WS_CNT) + 64 * u.pm;
#pragma unroll
        for (int ai = 0; ai < 2; ++ai) { f32x4 pre[4][2][2];
#pragma unroll
            for (int m = 0; m < 4; ++m)
#pragma unroll
                for (int bj = 0; bj < 2; ++bj)
#pragma unroll
                    for (int n = 0; n < 2; ++n) pre[m][bj][n] = *(const f32x4*)(out + (size_t)(row0 + ai * HALF + m * 16) * ldc + col0 + bj * HALF + n * 16);
            asm volatile("" ::: "memory");
#pragma unroll
            for (int m = 0; m < 4; ++m) { const int row = row0 + ai * HALF + m * 16; float sq = 0.f;
#pragma unroll
                for (int bj = 0; bj < 2; ++bj)
#pragma unroll
                    for (int n = 0; n < 2; ++n) { const f32x4 o = pre[m][bj][n] + acc[ai][bj][m][n] * 0.5f; acc[ai][bj][m][n] = o;
                        sq += (o[0] * o[0] + o[1] * o[1]) + (o[2] * o[2] + o[3] * o[3]); }
                sq += __shfl_xor(sq, 16); sq += __shfl_xor(sq, 32); if (fq == 0) __hip_atomic_fetch_add(ss + row, sq, __ATOMIC_RELAXED, __HIP_MEMORY_SCOPE_AGENT); } }
        asm volatile("s_waitcnt vmcnt(0)" ::: "memory");
        if (fr == 0 && fq == 0) { __hip_atomic_fetch_add(cnt, 1u, __ATOMIC_RELAXED, __HIP_MEMORY_SCOPE_AGENT);
            unsigned spins = 0; while (__hip_atomic_load(cnt, __ATOMIC_RELAXED, __HIP_MEMORY_SCOPE_AGENT) < 64u && ++spins < (1u << 22)) __builtin_amdgcn_s_sleep(2); }
        asm volatile("" ::: "memory");
#pragma unroll
        for (int ai = 0; ai < 2; ++ai)
#pragma unroll
            for (int m = 0; m < 4; ++m) { const int row = row0 + ai * HALF + m * 16; const size_t off = (size_t)row * ldc + col0; const float rs = row_scale<1>(ss, row);
#pragma unroll
                for (int bj = 0; bj < 2; ++bj)
#pragma unroll
                    for (int n = 0; n < 2; ++n) { const size_t p = off + bj * HALF + n * 16; const f32x4 w4 = *(const f32x4*)(wfin + col0 + bj * HALF + n * 16); *(f32x4*)(out + p) = acc[ai][bj][m][n] * rs * w4; } }
    }
};
struct PanelOrder { int v;
    __host__ __device__ bool next(int i, Unit& u) const { if (i >= 2) return false; u.pm = 8 * (v >> 5) + 4 * i + ((v >> 3) & 3); u.pn = v & 7; return true; }
    __device__ __forceinline__ void a_ready(const Unit&) const {}
    __device__ __forceinline__ void done(const Unit&) const {}
};
}

namespace hg {
constexpr int QS = 136, TS = 72;
constexpr int OFF_QG = 0, OFF_KN = 17408, OFF_KLT = 34816, OFF_VT = 53248, OFF_AM = 57856, OFF_ST = 67072, OFF_TOT = 75776, OFF_GL = 77824, HG_LDS = 78336;
#define HG_MFMA(x, y, c) __builtin_amdgcn_mfma_f32_16x16x32_bf16((x), (y), (c), 0, 0, 0)
#define HG_LD8(off) (*(const LAS bf16x8*)(lds + (off)))
#define HG_BAR() asm volatile("s_waitcnt lgkmcnt(0)\n\ts_barrier" ::: "memory")
__device__ __forceinline__ void hgrn_unit(LAS unsigned char* lds, int b, int h, int vs, const bf16* QR, const _Float16* LF, const bf16* IO, bf16* OR_) {
    int tid_ = threadIdx.x; asm volatile("" : "+v"(tid_));
    const int tid = tid_, lane = tid & 63, wid = __builtin_amdgcn_readfirstlane(tid >> 6), fr = lane & 15, fq = lane >> 4;
    const size_t rowbase = (size_t)b * SEQ;
    constexpr int NCH = SEQ / 64;
    if (wid < 4) {
        const int ew = wid, t0 = 16 * ew;
        const unsigned* lp = (const unsigned*)(LF + (rowbase + t0) * 1024 + h * 128) + lane;
        const unsigned* qp = (const unsigned*)(QR + (rowbase + t0) * 1024 + h * 128) + lane;
        const int et = ew * 64 + lane, vrow = et >> 2, c8 = et & 3;
        const v4u* vp = (const v4u*)(IO + (rowbase + vrow) * 1024 + h * 128 + vs * 32 + 8 * c8);
        unsigned clf[16], cq[16], nlf[16], nq[16]; v4u cv, nv;
#pragma unroll
        for (int i = 0; i < 16; ++i) { clf[i] = lp[i * 512]; cq[i] = qp[i * 512]; nlf[i] = 0u; nq[i] = 0u; }
        cv = *vp; nv = cv;
        for (int n = 0; n < NCH; ++n) {
            if (n + 1 < NCH) { lp += 64 * 512; qp += 64 * 512; vp += 64 * 128;
#pragma unroll
                for (int i = 0; i < 16; ++i) { nlf[i] = lp[i * 512]; nq[i] = qp[i * 512]; }
                nv = *vp; }
            float qa[2][16], kb[2][16], tot[2];
#pragma unroll
            for (int e = 0; e < 2; ++e) { float run = 1.f;
#pragma unroll
                for (int i = 0; i < 16; ++i) { const unsigned short hb = (unsigned short)(e ? (clf[i] >> 16) : (clf[i] & 0xffffu)); const float kk = (float)__builtin_bit_cast(_Float16, hb);
                    run *= (1.f - kk); const float q = e ? bfhi(cq[i]) : bflo(cq[i]);
                    qa[e][i] = q * run; kb[e][i] = kk * __builtin_amdgcn_rcpf(run); }
                tot[e] = run; }
            ((LAS f32x2_m*)(lds + OFF_TOT))[ew * 64 + lane] = (f32x2_m){tot[0], tot[1]};
            HG_BAR();
            float eoff[2], ieoff[2], eGl[2];
            { const f32x2_m t0v = ((LAS f32x2_m*)(lds + OFF_TOT))[lane], t1v = ((LAS f32x2_m*)(lds + OFF_TOT))[64 + lane], t2v = ((LAS f32x2_m*)(lds + OFF_TOT))[128 + lane], t3v = ((LAS f32x2_m*)(lds + OFF_TOT))[192 + lane];
#pragma unroll
              for (int e = 0; e < 2; ++e) { const float off = (ew > 0 ? t0v[e] : 1.f) * (ew > 1 ? t1v[e] : 1.f) * (ew > 2 ? t2v[e] : 1.f);
                  eoff[e] = off; ieoff[e] = __builtin_amdgcn_rcpf(off); eGl[e] = (t0v[e] * t1v[e]) * (t2v[e] * t3v[e]); } }
            unsigned klp[2][8];
#pragma unroll
            for (int i = 0; i < 16; i += 2) { float kl[2][2];
#pragma unroll
                for (int d = 0; d < 2; ++d) { const float kn0 = kb[0][i + d] * ieoff[0], kn1 = kb[1][i + d] * ieoff[1];
                    ((LAS unsigned*)(lds + OFF_QG))[(t0 + i + d) * (QS / 2) + lane] = pkbf(qa[0][i + d] * eoff[0], qa[1][i + d] * eoff[1]);
                    ((LAS unsigned*)(lds + OFF_KN))[(t0 + i + d) * (QS / 2) + lane] = pkbf(kn0, kn1);
                    kl[0][d] = kn0 * eGl[0]; kl[1][d] = kn1 * eGl[1]; }
                klp[0][i >> 1] = pkbf(kl[0][0], kl[0][1]); klp[1][i >> 1] = pkbf(kl[1][0], kl[1][1]); }
#pragma unroll
            for (int e = 0; e < 2; ++e) { const int k = 2 * lane + e;
                *(LAS v4u*)(lds + OFF_KLT + (k * TS + t0) * 2) = (v4u){klp[e][0], klp[e][1], klp[e][2], klp[e][3]};
                *(LAS v4u*)(lds + OFF_KLT + (k * TS + t0 + 8) * 2) = (v4u){klp[e][4], klp[e][5], klp[e][6], klp[e][7]}; }
            if (ew == 0) ((LAS f32x2_m*)(lds + OFF_GL))[lane] = (f32x2_m){eGl[0], eGl[1]};
            { LAS bf16* vt = (LAS bf16*)(lds + OFF_VT) + (8 * c8) * TS + vrow;
              vt[0 * TS] = (bf16)(cv.x & 0xffffu); vt[1 * TS] = (bf16)(cv.x >> 16); vt[2 * TS] = (bf16)(cv.y & 0xffffu); vt[3 * TS] = (bf16)(cv.y >> 16);
              vt[4 * TS] = (bf16)(cv.z & 0xffffu); vt[5 * TS] = (bf16)(cv.z >> 16); vt[6 * TS] = (bf16)(cv.w & 0xffffu); vt[7 * TS] = (bf16)(cv.w >> 16); }
#pragma unroll
            for (int i = 0; i < 16; ++i) { clf[i] = nlf[i]; cq[i] = nq[i]; }
            cv = nv;
            HG_BAR();
        }
        HG_BAR(); HG_BAR();
    } else {
        const int mw = wid - 4;
        for (int i = tid - 256; i < 32 * QS / 2; i += 256) ((LAS unsigned*)(lds + OFF_ST))[i] = 0u;
        f32x4 sacc[2][2];
#pragma unroll
        for (int ki = 0; ki < 2; ++ki)
#pragma unroll
            for (int vj = 0; vj < 2; ++vj) sacc[ki][vj] = (f32x4){0.f, 0.f, 0.f, 0.f};
        bf16* op = OR_ + (rowbase + 16 * mw + fr) * 1024 + h * 128 + vs * 32 + 4 * fq;
        HG_BAR(); HG_BAR();
        for (int c = 0; c < NCH; ++c) {
            bf16x8 qgf[4], knf[4][4], stf[2][4], vtf[2][2], klf[2][2]; f32x4 glv[2];
#pragma unroll
            for (int kk = 0; kk < 4; ++kk) qgf[kk] = HG_LD8(OFF_QG + ((16 * mw + fr) * QS + 32 * kk + 8 * fq) * 2);
#pragma unroll
            for (int sj = 0; sj < 4; ++sj)
#pragma unroll
                for (int kk = 0; kk < 4; ++kk) knf[sj][kk] = (sj <= mw) ? HG_LD8(OFF_KN + ((16 * sj + fr) * QS + 32 * kk + 8 * fq) * 2) : qgf[kk];
#pragma unroll
            for (int vj = 0; vj < 2; ++vj) {
#pragma unroll
                for (int kk = 0; kk < 4; ++kk) stf[vj][kk] = HG_LD8(OFF_ST + ((16 * vj + fr) * QS + 32 * kk + 8 * fq) * 2);
#pragma unroll
                for (int ss = 0; ss < 2; ++ss) vtf[vj][ss] = HG_LD8(OFF_VT + ((16 * vj + fr) * TS + 32 * ss + 8 * fq) * 2); }
#pragma unroll
            for (int ki = 0; ki < 2; ++ki) { const int kg = 2 * mw + ki; glv[ki] = *(const LAS f32x4*)(lds + OFF_GL + (16 * kg + 4 * fq) * 4);
#pragma unroll
                for (int ss = 0; ss < 2; ++ss) klf[ki][ss] = HG_LD8(OFF_KLT + ((16 * kg + fr) * TS + 32 * ss + 8 * fq) * 2); }
            f32x4 a[4], o[2];
#pragma unroll
            for (int sj = 0; sj < 4; ++sj) { a[sj] = (f32x4){0.f, 0.f, 0.f, 0.f};
                if (sj <= mw) {
#pragma unroll
                    for (int kk = 0; kk < 4; ++kk) a[sj] = HG_MFMA(knf[sj][kk], qgf[kk], a[sj]);
                    if (sj == mw) {
#pragma unroll
                        for (int r = 0; r < 4; ++r) if (4 * fq + r > fr) a[sj][r] = 0.f; }
                } }
#pragma unroll
            for (int vj = 0; vj < 2; ++vj) { o[vj] = (f32x4){0.f, 0.f, 0.f, 0.f};
#pragma unroll
                for (int kk = 0; kk < 4; ++kk) o[vj] = HG_MFMA(stf[vj][kk], qgf[kk], o[vj]); }
#pragma unroll
            for (int ki = 0; ki < 2; ++ki)
#pragma unroll
                for (int vj = 0; vj < 2; ++vj) { sacc[ki][vj] = sacc[ki][vj] * glv[ki]; sacc[ki][vj] = HG_MFMA(klf[ki][0], vtf[vj][0], sacc[ki][vj]); sacc[ki][vj] = HG_MFMA(klf[ki][1], vtf[vj][1], sacc[ki][vj]); }
#pragma unroll
            for (int sj = 0; sj < 4; ++sj) *(LAS v2u*)(lds + OFF_AM + ((16 * mw + fr) * TS + 16 * sj + 4 * fq) * 2) = (v2u){pkbf(a[sj][0], a[sj][1]), pkbf(a[sj][2], a[sj][3])};
            HG_BAR();
            bf16x8 amf[2];
#pragma unroll
            for (int ss = 0; ss < 2; ++ss) amf[ss] = HG_LD8(OFF_AM + ((16 * mw + fr) * TS + 32 * ss + 8 * fq) * 2);
#pragma unroll
            for (int ki = 0; ki < 2; ++ki)
#pragma unroll
                for (int vj = 0; vj < 2; ++vj) *(LAS v2u*)(lds + OFF_ST + ((16 * vj + fr) * QS + 16 * (2 * mw + ki) + 4 * fq) * 2) = (v2u){pkbf(sacc[ki][vj][0], sacc[ki][vj][1]), pkbf(sacc[ki][vj][2], sacc[ki][vj][3])};
#pragma unroll
            for (int vj = 0; vj < 2; ++vj) {
#pragma unroll
                for (int ss = 0; ss < 2; ++ss) if (32 * ss <= 16 * mw + 15) o[vj] = HG_MFMA(vtf[vj][ss], amf[ss], o[vj]);
                *(v2u*)(op + (size_t)c * 64 * 1024 + 16 * vj) = (v2u){pkbf(o[vj][0], o[vj][1]), pkbf(o[vj][2], o[vj][3])}; }
            HG_BAR();
        }
    }
}
#undef HG_MFMA
#undef HG_LD8
}

__device__ __forceinline__ void tr_item(const float* W, const float* nw, int K, int N, bf16* WT, int k0, int n0, int drow0, LAS float* scr, int lane) {
    { const int r = lane >> 3, c4 = lane & 7; f32x4 v[8];
#pragma unroll
      for (int i = 0; i < 8; ++i) v[i] = *(const f32x4*)(W + (size_t)(k0 + 8 * i + r) * N + n0 + 4 * c4);
#pragma unroll
      for (int i = 0; i < 8; ++i) { LAS float* d = scr + (8 * i + r) * 33 + 4 * c4; const float s = nw ? nw[k0 + 8 * i + r] : 1.f; d[0] = v[i].x * s; d[1] = v[i].y * s; d[2] = v[i].z * s; d[3] = v[i].w * s; } }
    asm volatile("s_waitcnt lgkmcnt(0)" ::: "memory");
    const int c = lane & 7;
#pragma unroll
    for (int j = 0; j < 4; ++j) { const int n = (lane >> 3) + 8 * j; const LAS float* s = scr + (8 * c) * 33 + n;
        v4u o; o.x = pkbf(s[0 * 33], s[1 * 33]); o.y = pkbf(s[2 * 33], s[3 * 33]); o.z = pkbf(s[4 * 33], s[5 * 33]); o.w = pkbf(s[6 * 33], s[7 * 33]);
        *(v4u*)(WT + (size_t)(drow0 + n) * K + k0 + 8 * c) = o; }
    asm volatile("s_waitcnt lgkmcnt(0)" ::: "memory");
}
template <int MODE> __device__ __forceinline__ void conv_mat(const float* W, const float* nw, int K, int N, bf16* WT, LAS float* scr, int gw, int NGW, int lane) {
    const int nblk = N / 32, nitems = (K / 64) * nblk;
    for (int it = gw; it < nitems; it += NGW) { const int kb = it / nblk, nb = it % nblk, n0 = 32 * nb; int d = n0;
        if (MODE == 1) { d = (n0 < DFF) ? 256 * (n0 / 128) + (n0 % 128) : 256 * ((n0 - DFF) / 128) + 128 + ((n0 - DFF) % 128); }
        tr_item(W, nw, K, N, WT, 64 * kb, n0, d, scr, lane); }
}
__device__ __forceinline__ void prep_rows_bf16(const float* X, float* rs, bf16* Hout, int gw, int NGW, int lane) {
    const bool xcd_deal = (NGW == 2048);
    for (int it = 0, m = xcd_deal ? gw * 8 : gw; m < M && (!xcd_deal || it < 8); ++it, m += xcd_deal ? 1 : NGW) { const f32x4* xr = (const f32x4*)(X + (size_t)m * DM) + lane; f32x4 v[8]; float s = 0.f;
#pragma unroll
        for (int j = 0; j < 8; ++j) { v[j] = xr[64 * j]; s += (v[j].x * v[j].x + v[j].y * v[j].y) + (v[j].z * v[j].z + v[j].w * v[j].w); }
        const float rstd = 1.0f / sqrtf(wave_sum(s) * (1.f / DM) + EPS);
        if (lane == 0) rs[m] = rstd;
        v2u* o = (v2u*)(Hout + (size_t)m * DM) + lane;
#pragma unroll
        for (int j = 0; j < 8; ++j) o[64 * j] = (v2u){pkbf(v[j].x, v[j].y), pkbf(v[j].z, v[j].w)}; }
}
__device__ __forceinline__ void norm_rows_f32_inplace(float* X, const float* ss, const float* w, int gw, int NGW, int lane) {
    for (int m = gw; m < M; m += NGW) { f32x4* xr = (f32x4*)(X + (size_t)m * DM) + lane; f32x4 v[8];
#pragma unroll
        for (int j = 0; j < 8; ++j) v[j] = xr[64 * j];
        const float rstd = epi::row_scale<1>(ss, m);
#pragma unroll
        for (int j = 0; j < 8; ++j) { const f32x4 ww = ((const f32x4*)w)[64 * j + lane]; xr[64 * j] = v[j] * rstd * ww; } }
}
__device__ __forceinline__ void unpack16(const bf16* p, float (&v)[16]) { const v4u a = *(const v4u*)p, b = *(const v4u*)(p + 8);
    v[0] = bflo(a.x); v[1] = bfhi(a.x); v[2] = bflo(a.y); v[3] = bfhi(a.y); v[4] = bflo(a.z); v[5] = bfhi(a.z); v[6] = bflo(a.w); v[7] = bfhi(a.w);
    v[8] = bflo(b.x); v[9] = bfhi(b.x); v[10] = bflo(b.y); v[11] = bfhi(b.y); v[12] = bflo(b.z); v[13] = bfhi(b.z); v[14] = bflo(b.w); v[15] = bfhi(b.w); }
__device__ __forceinline__ void pack16(bf16* p, const float (&v)[16]) {
    *(v4u*)p = (v4u){pkbf(v[0], v[1]), pkbf(v[2], v[3]), pkbf(v[4], v[5]), pkbf(v[6], v[7])}; *(v4u*)(p + 8) = (v4u){pkbf(v[8], v[9]), pkbf(v[10], v[11]), pkbf(v[12], v[13]), pkbf(v[14], v[15])}; }
__device__ __forceinline__ void combine_rows(const bf16* O1, const bf16* O2, const bf16* OR_, const bf16* Gs, bf16* YA, bf16* YR, float lam, const float* subln, const float* gnorm, int gw, int NGW, int lane) {
    const bool xcd_deal = (NGW == 2048);
    float wa[16], wg[16];
#pragma unroll
    for (int i = 0; i < 16; ++i) { wa[i] = subln[16 * (lane & 7) + i] * 0.8f; wg[i] = gnorm[16 * (lane & 7) + i]; }
    for (int it = 0, m = xcd_deal ? gw * 8 : gw; m < M && (!xcd_deal || it < 8); it += 2, m += xcd_deal ? 2 : 2 * NGW) {
        const int mB = xcd_deal ? m + 1 : m + NGW; const bool hasB = mB < M;
        const size_t pA = (size_t)m * 1024 + 16 * lane, pB = (size_t)(hasB ? mB : m) * 1024 + 16 * lane;
        v4u raw[2][8];
#pragma unroll
        for (int q = 0; q < 2; ++q) { const size_t p = q ? pB : pA;
            raw[q][0] = *(const v4u*)(O1 + p); raw[q][1] = *(const v4u*)(O1 + p + 8); raw[q][2] = *(const v4u*)(O2 + p); raw[q][3] = *(const v4u*)(O2 + p + 8);
            raw[q][4] = *(const v4u*)(OR_ + p); raw[q][5] = *(const v4u*)(OR_ + p + 8); raw[q][6] = *(const v4u*)(Gs + p); raw[q][7] = *(const v4u*)(Gs + p + 8); }
        asm volatile("" ::: "memory");
#pragma unroll
        for (int q = 0; q < 2; ++q) { if (q == 1 && !hasB) break; const size_t p = q ? pB : pA;
            float a[16], b2[16], r[16], g[16];
#define CR_UNP(dst, lo, hi) do { const v4u x_ = raw[q][lo], y_ = raw[q][hi]; dst[0] = bflo(x_.x); dst[1] = bfhi(x_.x); dst[2] = bflo(x_.y); dst[3] = bfhi(x_.y); dst[4] = bflo(x_.z); dst[5] = bfhi(x_.z); dst[6] = bflo(x_.w); dst[7] = bfhi(x_.w); \
            dst[8] = bflo(y_.x); dst[9] = bfhi(y_.x); dst[10] = bflo(y_.y); dst[11] = bfhi(y_.y); dst[12] = bflo(y_.z); dst[13] = bfhi(y_.z); dst[14] = bflo(y_.w); dst[15] = bfhi(y_.w); } while (0)
            CR_UNP(a, 0, 1); CR_UNP(b2, 2, 3); CR_UNP(r, 4, 5); CR_UNP(g, 6, 7);
#undef CR_UNP
            float sa = 0.f, sr = 0.f;
#pragma unroll
            for (int i = 0; i < 16; ++i) { a[i] = a[i] - lam * b2[i]; sa += a[i] * a[i]; sr += r[i] * r[i]; }
            sa += __shfl_xor(sa, 1); sa += __shfl_xor(sa, 2); sa += __shfl_xor(sa, 4); sr += __shfl_xor(sr, 1); sr += __shfl_xor(sr, 2); sr += __shfl_xor(sr, 4);
            const float ra = 1.0f / sqrtf(sa * (1.f / 128.f) + EPS), rr = 1.0f / sqrtf(sr * (1.f / 128.f) + EPS);
#pragma unroll
            for (int i = 0; i < 16; ++i) { a[i] = a[i] * ra * wa[i]; r[i] = r[i] * rr * wg[i] * g[i]; }
            pack16(YA + p, a); pack16(YR + p, r); } }
}

#define XB_TMO      128
#define XB_XCNT(j)  (256  + 64 * (j))
#define XB_XSUB(j)  (1280 + 64 * (j))
#define XB_XGEN(j)  (2304 + 64 * (j))
#define XB_TOP      3328
#define XB_TOPGEN   3392
#define XCD_BAR_WORDS 3456
#define XB_SPIN_CAP (1u << 18)

__device__ __forceinline__ unsigned xb_ld(unsigned* p)              { return __hip_atomic_load(p, __ATOMIC_RELAXED, __HIP_MEMORY_SCOPE_AGENT); }
__device__ __forceinline__ unsigned xb_add(unsigned* p, unsigned v) { return __hip_atomic_fetch_add(p, v, __ATOMIC_RELAXED, __HIP_MEMORY_SCOPE_AGENT); }
__device__ __forceinline__ unsigned xb_xcc_id() { return (unsigned)__builtin_amdgcn_s_getreg((3 << 11) | 20) & 0xFu; }
#define XB_SPIN(cond, bar) do { unsigned _sp = 0; while (cond) { __builtin_amdgcn_s_sleep(1); \
    if ((++_sp & 255u) == 0u) { if (xb_ld(&(bar)[XB_TMO])) break; if (_sp > XB_SPIN_CAP) { atomicAdd(&(bar)[XB_TMO], 1u); break; } } } } while (0)

struct XcdBarrier {
    unsigned* bar; unsigned x;
    volatile LAS unsigned* st;
};

__device__ __forceinline__ XcdBarrier xcd_barrier_post(unsigned* bar, volatile LAS unsigned* st) {
    XcdBarrier b; b.bar = bar; b.x = xb_xcc_id(); b.st = st;
    if (threadIdx.x == 0) (void)xb_add(&bar[XB_XCNT(b.x)], 1u);
    return b;
}
__device__ __forceinline__ void xcd_barrier_complete(unsigned* bar, unsigned x, unsigned& nloc, unsigned& nx) {
    const unsigned G = gridDim.x * gridDim.y * gridDim.z;
    unsigned sum, cnt, mine, sp = 0u;
    for (;;) {
        sum = 0u; cnt = 0u; mine = 0u;
#pragma unroll
        for (unsigned j = 0; j < 16; ++j) { const unsigned c = xb_ld(&bar[XB_XCNT(j)]); sum += c; cnt += (c > 0u) ? 1u : 0u; mine = (j == x) ? c : mine; }
        if (sum == G) break;
        __builtin_amdgcn_s_sleep(1);
        if ((++sp & 255u) == 0u) { if (xb_ld(&bar[XB_TMO])) break; if (sp > XB_SPIN_CAP) { atomicAdd(&bar[XB_TMO], 1u); break; } }
    }
    nloc = mine > 0u ? mine : 1u; nx = cnt > 0u ? cnt : 1u;
}

__device__ __forceinline__ void xcd_barrier(const XcdBarrier& b) {
    asm volatile("s_waitcnt vmcnt(0)" ::: "memory");
    __syncthreads();
    if (threadIdx.x == 0) {
        unsigned* bar = b.bar;
        __builtin_amdgcn_s_waitcnt(0);
        unsigned nloc = b.st[0], nx = b.st[1];
        if (nloc == 0u) { xcd_barrier_complete(bar, b.x, nloc, nx); b.st[0] = nloc; b.st[1] = nx; }
        const unsigned old = xb_add(&bar[XB_XSUB(b.x)], 1u);
        const unsigned gen = old / nloc;
        if (old + 1u == (gen + 1u) * nloc) {
            __builtin_amdgcn_fence(__ATOMIC_RELEASE, "agent");
            asm volatile("s_waitcnt vmcnt(0)" ::: "memory");
            const unsigned og = xb_add(&bar[XB_TOP], 1u);
            const unsigned tg = og / nx;
            if (og + 1u == (tg + 1u) * nx) xb_add(&bar[XB_TOPGEN], 1u);
            else XB_SPIN(xb_ld(&bar[XB_TOPGEN]) == tg, bar);
            __builtin_amdgcn_fence(__ATOMIC_ACQUIRE, "agent");
            xb_add(&bar[XB_XGEN(b.x)], 1u);
            asm volatile("s_waitcnt vmcnt(0)" ::: "memory");
        } else {
            XB_SPIN(xb_ld(&bar[XB_XGEN(b.x)]) == gen, bar);
            __builtin_amdgcn_fence(__ATOMIC_ACQUIRE, "agent");
            asm volatile("s_waitcnt vmcnt(0)" ::: "memory");
        }
    }
    __syncthreads();
}

struct Args { const float* in[20]; float* out; unsigned char* ws; };
enum { I_X = 0, I_F1N, I_F1I, I_F1O, I_MIXN, I_WIN, I_LQ1, I_LK1, I_LQ2, I_LK2, I_SUBLN, I_LBRAW, I_GNORM, I_WPA, I_WPR, I_WOUT, I_F2N, I_F2I, I_F2O, I_FINN };

__global__ void __launch_bounds__(512, 2) fwd_megakernel(Args a) {
    extern __shared__ __attribute__((aligned(16))) unsigned char lds_raw[];
    LAS unsigned char* lds = (LAS unsigned char*)lds_raw;
    cg::grid_group grid = cg::this_grid();
#define GRID_SYNC() do { asm volatile("s_waitcnt vmcnt(0) lgkmcnt(0)" ::: "memory"); __syncthreads(); grid.sync(); if (tid == 0) { __builtin_amdgcn_fence(__ATOMIC_ACQUIRE, "agent"); asm volatile("s_waitcnt vmcnt(0)" ::: "memory"); } __syncthreads(); } while (0)
    const int tid = threadIdx.x, lane = tid & 63, wave = __builtin_amdgcn_readfirstlane(tid >> 6);
    const int G = gridDim.x, bx = blockIdx.x, vcu = (G % 8 == 0) ? (bx % 8) * (G / 8) + bx / 8 : bx;
    const int gw = vcu * 8 + wave, NGW = G * 8;
    unsigned char* ws = a.ws;
    float* ropeC = (float*)(ws + WS_ROPE); float* ropeS = ropeC + SEQ * 8;
    bf16* WFI = (bf16*)(ws + WS_WFI); bf16* WFO = (bf16*)(ws + WS_WFO); bf16* WIN = (bf16*)(ws + WS_WIN);
    bf16* WPA = (bf16*)(ws + WS_WPA); bf16* WPR = (bf16*)(ws + WS_WPR); bf16* WWO = (bf16*)(ws + WS_WWO);
    bf16* H = (bf16*)(ws + WS_H); bf16* ACT = (bf16*)(ws + WS_BIG); bf16* P = (bf16*)(ws + WS_BIG);
    bf16* O1 = (bf16*)(ws + WS_Y); bf16* O2 = O1 + PBUF; bf16* T1 = (bf16*)(ws + WS_Y);
    bf16* YA = P + PB_QA * PBUF; bf16* YR = P + PB_KA * PBUF;
    float* out = a.out;
    float* RS0 = (float*)(ws + WS_SS); float* SS1 = RS0 + M; float* SS2 = SS1 + M; float* SS3 = SS2 + M;
    LAS float* scr = (LAS float*)(lds + wave * 16384);
    using pg8::Gemm; using pg8::StaticOrder; using pg8::gemm_phase;
    for (int u = tid; u < (LDS_BYTES - RING_BYTES) / 4; u += 512) ((LAS unsigned*)(lds + RING_BYTES))[u] = 0u;
    __syncthreads();
#define XSYNC() xcd_barrier(bar)

    for (int i = bx * 512 + tid; i < (int)(WS_ZERO_BYTES / 4); i += G * 512) ((unsigned*)(ws + WS_BAR))[i] = 0u;
    conv_mat<1>(a.in[I_F1I], a.in[I_F1N], DM, 2 * DFF, WFI, scr, gw, NGW, lane);
    conv_mat<0>(a.in[I_F1O], nullptr, DFF, DM, WFO, scr, gw, NGW, lane);
    conv_mat<0>(a.in[I_WIN], a.in[I_MIXN], DM, 11264, WIN, scr, gw, NGW, lane);
    conv_mat<0>(a.in[I_WPA], nullptr, 1024, DM, WPA, scr, gw, NGW, lane);
    conv_mat<0>(a.in[I_WPR], nullptr, 1024, DM, WPR, scr, gw, NGW, lane);
    conv_mat<0>(a.in[I_WOUT], nullptr, DM, DM, WWO, scr, gw, NGW, lane);
    for (int id = bx * 512 + tid; id < SEQ * 8; id += G * 512) { const int pos = id >> 3, i = id & 7;
        const float inv = powf(500000.0f, -(float)(2 * i) / 16.0f); const float ang = (float)pos * inv; ropeC[id] = cosf(ang); ropeS[id] = sinf(ang); }
    prep_rows_bf16(a.in[I_X], RS0, H, gw, NGW, lane);
    GRID_SYNC();
    XcdBarrier bar = xcd_barrier_post((unsigned*)(ws + WS_BAR), (volatile LAS unsigned*)(lds + RING_BYTES + 64));
    { Gemm g{H, WFI, M, 2 * DFF, DM}; StaticOrder S; S.init(M, 2 * DFF, G, bx); epi::EpiSwiglu<0> E{ACT, DFF, RS0};
      gemm_phase<epi::EpiSwiglu<0>, StaticOrder, true, true>(lds, g, S, E); }
    XSYNC();
    { Gemm g{ACT, WFO, M, DM, DFF}; StaticOrder S; S.init(M, DM, G, bx); epi::EpiResid<1, 1, true> E{a.in[I_X], out, ws};
      gemm_phase<epi::EpiResid<1, 1, true>, StaticOrder, true, true>(lds, g, S, E); }
    XSYNC();
    { Gemm g{H, WIN, M, 11264, DM}; StaticOrder S; S.init(M, 11264, G, bx); epi::EpiMix E{ws, a.in[I_LBRAW]};
      gemm_phase<epi::EpiMix, StaticOrder, true, true>(lds, g, S, E); }
    XSYNC();
    for (int u = vcu; u < 256; u += G) { const int pr = u & 3, bh = u >> 2, b = bh >> 3, h = bh & 7;
        for (int j = 0; j < 2; ++j)
            for (int half = 0; half < 2; ++half)
                for (int e = 0; e < 2; ++e) { const int qb = e == 0 ? 7 - pr : pr;
                    attn_body::attn_unit<8>(b, 2 * h + j, 2 * h + half, qb, (const attn_body::bf16*)(P + PB_QA * PBUF), (const attn_body::bf16*)(P + PB_KA * PBUF), (const attn_body::bf16*)(P + PB_VA * PBUF),
                                            (attn_body::bf16*)(j == 0 ? O1 : O2), (char*)lds_raw); }
        hg::hgrn_unit(lds, b, h, pr, P + PB_QR * PBUF, (const _Float16*)(P + PB_LF * PBUF), P + PB_IO * PBUF, (bf16*)(ws + WS_OR));
    }
    XSYNC();
    { const float d1 = wave_sum(a.in[I_LQ1][lane] * a.in[I_LK1][lane]), d2 = wave_sum(a.in[I_LQ2][lane] * a.in[I_LK2][lane]);
      const float lam = fexp(d1) - fexp(d2) + 0.2f;
      combine_rows(O1, O2, (const bf16*)(ws + WS_OR), P + PB_G * PBUF, YA, YR, lam, a.in[I_SUBLN], a.in[I_GNORM], gw, NGW, lane); }
    XSYNC();
    { StaticOrder S; S.init(M, DM, G, bx); const unsigned char* GA = ws + WS_WFI; const unsigned char* GB = GA + (size_t)M * DM;
      { Gemm g{YA, WPA, M, DM, 1024}; epi::EpiGate<0> E{T1, GA}; gemm_phase<epi::EpiGate<0>, StaticOrder, true, true>(lds, g, S, E); }
      { Gemm g{YR, WPR, M, DM, 1024}; epi::EpiGate<1> E{T1, GB}; gemm_phase<epi::EpiGate<1>, StaticOrder, true, true>(lds, g, S, E); } }
    XSYNC();
    conv_mat<1>(a.in[I_F2I], a.in[I_F2N], DM, 2 * DFF, WFI, scr, gw, NGW, lane);
    conv_mat<0>(a.in[I_F2O], nullptr, DFF, DM, WFO, scr, gw, NGW, lane);
    asm volatile("s_waitcnt vmcnt(0) lgkmcnt(0)" ::: "memory"); __syncthreads();
    { Gemm g{T1, WWO, M, DM, DM}; StaticOrder S; S.init(M, DM, G, bx); epi::EpiResid<1, 2, false> E{out, out, ws};
      gemm_phase<epi::EpiResid<1, 2, false>, StaticOrder, true, true>(lds, g, S, E); }
    XSYNC();
    { Gemm g{H, WFI, M, 2 * DFF, DM}; StaticOrder S; S.init(M, 2 * DFF, G, bx); epi::EpiSwiglu<1> E{ACT, DFF, SS2};
      gemm_phase<epi::EpiSwiglu<1>, StaticOrder, true, true>(lds, g, S, E); }
    XSYNC();
    if (G == 256) {
      Gemm g{ACT, WFO, M, DM, DFF}; epi::PanelOrder S{vcu}; epi::EpiFinal E{out, ws, a.in[I_FINN]};
      gemm_phase<epi::EpiFinal, epi::PanelOrder, true, true>(lds, g, S, E);
    } else {
      { Gemm g{ACT, WFO, M, DM, DFF}; StaticOrder S; S.init(M, DM, G, bx); epi::EpiResid<2, 3, true> E{out, out, ws};
        gemm_phase<epi::EpiResid<2, 3, true>, StaticOrder, true, true>(lds, g, S, E); }
      XSYNC();
      norm_rows_f32_inplace(out, SS3, a.in[I_FINN], gw, NGW, lane);
    }
}

extern "C" void kernel_launch(void* const* d_in, const int* in_sizes, int n_in, void* d_out, int out_size, void* d_ws, size_t ws_size, hipStream_t stream) {
    static int grid = 0;
    if (grid == 0) {
        if (n_in != 20 || out_size != M * DM || ws_size < WS_END) { fprintf(stderr, "kernel_launch: unexpected shapes (n_in %d out %d ws %zu)\n", n_in, out_size, ws_size); grid = -1; return; }
        int dev = 0, cus = 0, per_cu = 0;
        hipGetDevice(&dev); hipDeviceGetAttribute(&cus, hipDeviceAttributeMultiprocessorCount, dev);
        if (hipFuncSetAttribute((const void*)fwd_megakernel, hipFuncAttributeMaxDynamicSharedMemorySize, LDS_BYTES) != hipSuccess) { fprintf(stderr, "kernel_launch: hipFuncSetAttribute failed\n"); grid = -1; return; }
        if (hipOccupancyMaxActiveBlocksPerMultiprocessor(&per_cu, (const void*)fwd_megakernel, 512, LDS_BYTES) != hipSuccess || per_cu < 1) { fprintf(stderr, "kernel_launch: occupancy query says %d\n", per_cu); per_cu = 1; }
        (void)hipGetLastError();
        grid = cus * 1;
    }
    if (grid < 0) return;
    Args a{};
    for (int i = 0; i < 20; ++i) a.in[i] = (const float*)d_in[i];
    a.out = (float*)d_out; a.ws = (unsigned char*)d_ws;
    void* args[] = {&a};
    hipError_t e = hipLaunchCooperativeKernel((const void*)fwd_megakernel, dim3(grid), dim3(512), args, LDS_BYTES, stream);
    if (e != hipSuccess) fprintf(stderr, "cooperative launch failed: %s (grid %d)\n", hipGetErrorString(e), grid);
}
```

```cpp
#include <hip/hip_runtime.h>
#include <cstdio>
#include <cstdint>
namespace pg8 {
#define PG8_LAS __attribute__((address_space(3)))
typedef unsigned short bf16_t;
typedef short bf16x8 __attribute__((ext_vector_type(8)));
typedef float f32x4 __attribute__((ext_vector_type(4)));
typedef unsigned u32x4 __attribute__((ext_vector_type(4)));
constexpr int BM = 256, BK = 64, HALF = 128, HTB = HALF * BK * 2  , STAGE_BYTES = 8 * HTB, NXCD = 8, WGM = 8;

__host__ __device__ __forceinline__ int lds_byte(int r, int c) { const int st = (r >> 4) * 2 + (c >> 5), rr = r & 15, cc = c & 31, ob = rr * 64 + cc * 2; return st * 1024 + (ob ^ (((ob >> 9) & 1) << 5)); }
__host__ __device__ __forceinline__ void stage_rc(int b, int& R, int& C) { const int st = b / 1024, sb = b % 1024, swz = sb ^ (((sb >> 9) & 1) << 5); R = (st >> 1) * 16 + swz / 64; C = (st & 1) * 32 + (swz % 64) / 2; }
__host__ __device__ __forceinline__ int perm32(int rho) { const int n = rho >> 4, i = rho & 15; return 8 * (i >> 2) + 4 * n + (i & 3); }

struct Unit { int pm, pn; };
struct Gemm { const bf16_t* A; const bf16_t* Bt; int M, N, K; };

struct StaticOrder {
    int nM, nN, nwg, G, c;
    __host__ __device__ void init(int M, int N, int G_, int c_) { nM = M / BM; nN = N / BM; nwg = nM * nN; G = G_; c = c_; }
    __host__ __device__ bool next(int i, Unit& u) const {
        const long L = (long)i * G + c; if (L >= nwg) return false;
        int wgid = (int)L; { const int q = nwg / NXCD, r = nwg % NXCD, xcd = wgid % NXCD, off = wgid / NXCD; wgid = (xcd < r ? xcd * (q + 1) : r * (q + 1) + (xcd - r) * q) + off; }
        const int nig = WGM * nN, gid = wgid / nig, fm = gid * WGM, gsz = (nM - fm) < WGM ? (nM - fm) : WGM;
        u.pm = fm + ((wgid % nig) % gsz); u.pn = (wgid % nig) / gsz; return true;
    }
    __device__ __forceinline__ void a_ready(const Unit&) const {}
    __device__ __forceinline__ void done(const Unit&) const {}
};

__device__ __forceinline__ unsigned cvt_pk_bf16(float lo, float hi) { unsigned r; asm volatile("v_cvt_pk_bf16_f32 %0, %1, %2" : "=v"(r) : "v"(lo), "v"(hi)); return r; }
typedef float f32x2 __attribute__((ext_vector_type(2)));
template <class Epi, class Sched, bool ALIGN_EPI = false, bool SP2 = false>
__device__ __forceinline__ void gemm_phase(PG8_LAS unsigned char* lds, const Gemm g, const Sched& S, const Epi& E) {
    int tid_ = threadIdx.x; asm volatile("" : "+v"(tid_));
    const int tid = tid_, wid = __builtin_amdgcn_readfirstlane(tid >> 6), lane = tid & 63, wr = wid >> 2, wc = wid & 3, fr = lane & 15, fq = lane >> 4;
    const int K = g.K, nt = K / BK;
    unsigned voffA[2], voffB[2];
#pragma unroll
    for (int i = 0; i < 2; ++i) { int R, C; stage_rc(tid * 16 + i * 8192, R, C); const int Rb = Epi::PERM ? ((R & ~31) + perm32(R & 31)) : R;
        voffA[i] = (unsigned)(R * K + C) * 2u; voffB[i] = (unsigned)(Rb * K + C) * 2u; }
    const size_t kstep = (size_t)(BK * 2);
    const size_t hstep = (size_t)HALF * K * 2;
    const size_t tstep = 2 * hstep;
    const unsigned ldsw = (unsigned)wid * 1024u;
    const int aoff = lds_byte(wr * 64 + fr, fq * 8), boff = lds_byte(wc * 32 + fr, fq * 8);
#define PG8_SA(b, h) (((b) * 2 + (h)) * HTB)
#define PG8_SB(b, h) ((4 + (b) * 2 + (h)) * HTB)
#define PG8_STAGE(bufoff, gbase, voff) do { _Pragma("unroll") for (int _i = 0; _i < 2; ++_i) \
        __builtin_amdgcn_global_load_lds((const unsigned*)((const char*)(gbase) + (voff)[_i]), (PG8_LAS unsigned*)(lds + (bufoff) + ldsw + _i * 8192), 16, 0, 0); } while (0)
#define PG8_LDA(dst, b, h) do { _Pragma("unroll") for (int m = 0; m < 4; ++m) _Pragma("unroll") for (int k = 0; k < 2; ++k) dst[m][k] = *(const PG8_LAS bf16x8*)(lds + PG8_SA(b, h) + aoff + m * 2048 + k * 1024); } while (0)
#define PG8_LDB(dst, b, h) do { _Pragma("unroll") for (int n = 0; n < 2; ++n) _Pragma("unroll") for (int k = 0; k < 2; ++k) dst[n][k] = *(const PG8_LAS bf16x8*)(lds + PG8_SB(b, h) + boff + n * 2048 + k * 1024); } while (0)
#define PG8_MMA(ai, bj, At, Bt) do { __builtin_amdgcn_s_setprio(1); _Pragma("unroll") for (int m = 0; m < 4; ++m) _Pragma("unroll") for (int n = 0; n < 2; ++n) _Pragma("unroll") for (int k = 0; k < 2; ++k) \
        acc[ai][bj][m][n] = __builtin_amdgcn_mfma_f32_16x16x32_bf16(Bt[n][k], At[m][k], acc[ai][bj][m][n], 0, 0, 0); __builtin_amdgcn_s_setprio(0); } while (0)
#define PG8_WAIT_V(n) asm volatile("s_waitcnt vmcnt(" #n ")" ::: "memory")
#define PG8_WAIT_L(n) asm volatile("s_waitcnt lgkmcnt(" #n ")" ::: "memory")
#define PG8_BAR __builtin_amdgcn_s_barrier()
#define PG8_SCHED __builtin_amdgcn_sched_barrier(0)
    Unit cur, nxt; int ui = 0;
    if (!S.next(0, cur)) return;
    f32x4 acc[2][2][4][2];
#pragma unroll
    for (int a = 0; a < 2; ++a)
#pragma unroll
        for (int b = 0; b < 2; ++b)
#pragma unroll
            for (int m = 0; m < 4; ++m)
#pragma unroll
                for (int n = 0; n < 2; ++n) acc[a][b][m][n] = (f32x4){0.f, 0.f, 0.f, 0.f};
    bf16x8 At[4][2], B0[2][2], B1[2][2];
    const char* cA = (const char*)g.A + (size_t)cur.pm * tstep; const char* cB = (const char*)g.Bt + (size_t)cur.pn * tstep;
    S.a_ready(cur);
    if constexpr (SP2) {
        PG8_STAGE(PG8_SB(0, 0), cB, voffB); PG8_STAGE(PG8_SB(0, 1), cB + hstep, voffB); PG8_STAGE(PG8_SA(0, 0), cA, voffA); PG8_STAGE(PG8_SA(0, 1), cA + hstep, voffA);
        if (wr == 1) PG8_BAR;
        PG8_WAIT_V(2); PG8_BAR;
        PG8_STAGE(PG8_SB(1, 0), cB + kstep, voffB); PG8_STAGE(PG8_SA(1, 0), cA + kstep, voffA); PG8_STAGE(PG8_SB(1, 1), cB + hstep + kstep, voffB);
        PG8_WAIT_V(6); PG8_BAR;
    } else {
        PG8_STAGE(PG8_SB(0, 0), cB, voffB); PG8_STAGE(PG8_SA(0, 0), cA, voffA); PG8_STAGE(PG8_SB(0, 1), cB + hstep, voffB); PG8_STAGE(PG8_SA(0, 1), cA + hstep, voffA);
        if (wr == 1) PG8_BAR;
        PG8_WAIT_V(4); PG8_BAR;
        PG8_STAGE(PG8_SB(1, 0), cB + kstep, voffB); PG8_STAGE(PG8_SA(1, 0), cA + kstep, voffA); PG8_STAGE(PG8_SB(1, 1), cB + hstep + kstep, voffB);
        PG8_WAIT_V(6); PG8_BAR;
    }
    for (;;) {
        const bool has_next = S.next(ui + 1, nxt);
        const char* nA = has_next ? (const char*)g.A + (size_t)nxt.pm * tstep : cA; const char* nB = has_next ? (const char*)g.Bt + (size_t)nxt.pn * tstep : cB;
        for (int t = 0; t < nt; t += 2) {
            const bool last = (t == nt - 2);
            const char* a1 = cA + (size_t)(t + 1) * kstep;
            const char* a2 = last ? nA : cA + (size_t)(t + 2) * kstep; const char* b2 = last ? nB : cB + (size_t)(t + 2) * kstep;
            const char* a3 = a2 + kstep; const char* b3 = b2 + kstep;
            if (last && has_next) S.a_ready(nxt);
            if constexpr (SP2) {
            PG8_LDB(B0, 0, 0); PG8_LDB(B1, 0, 1); PG8_SCHED; PG8_LDA(At, 0, 0); PG8_STAGE(PG8_SA(1, 1), a1 + hstep, voffA);
            PG8_WAIT_V(8); PG8_WAIT_L(0); PG8_BAR; PG8_MMA(0, 0, At, B0); PG8_MMA(0, 1, At, B1); PG8_BAR; PG8_SCHED;
            PG8_LDA(At, 0, 1); PG8_STAGE(PG8_SB(0, 0), b2, voffB); PG8_STAGE(PG8_SB(0, 1), b2 + hstep, voffB); PG8_STAGE(PG8_SA(0, 0), a2, voffA);
            PG8_WAIT_V(8); PG8_WAIT_L(0); PG8_BAR; PG8_MMA(1, 0, At, B0); PG8_MMA(1, 1, At, B1); PG8_BAR; PG8_SCHED;
            PG8_LDB(B0, 1, 0); PG8_LDB(B1, 1, 1); PG8_SCHED; PG8_LDA(At, 1, 0); PG8_STAGE(PG8_SA(0, 1), a2 + hstep, voffA);
            PG8_WAIT_V(8); PG8_WAIT_L(0); PG8_BAR; PG8_MMA(0, 0, At, B0); PG8_MMA(0, 1, At, B1); PG8_BAR; PG8_SCHED;
            PG8_LDA(At, 1, 1); PG8_STAGE(PG8_SB(1, 0), b3, voffB); PG8_STAGE(PG8_SB(1, 1), b3 + hstep, voffB); PG8_STAGE(PG8_SA(1, 0), a3, voffA);
            PG8_WAIT_V(8); PG8_WAIT_L(0); PG8_BAR; PG8_MMA(1, 0, At, B0); PG8_MMA(1, 1, At, B1); PG8_BAR; PG8_SCHED;
            } else {
            PG8_LDB(B0, 0, 0); PG8_SCHED; PG8_LDA(At, 0, 0); PG8_STAGE(PG8_SA(1, 1), a1 + hstep, voffA);
            PG8_WAIT_L(8); PG8_BAR; PG8_WAIT_L(0); PG8_MMA(0, 0, At, B0); PG8_BAR; PG8_SCHED;
            PG8_LDB(B1, 0, 1); PG8_STAGE(PG8_SB(0, 0), b2, voffB);
            PG8_BAR; PG8_WAIT_L(0); PG8_MMA(0, 1, At, B1); PG8_BAR;
            PG8_LDA(At, 0, 1); PG8_STAGE(PG8_SA(0, 0), a2, voffA);
            PG8_BAR; PG8_WAIT_L(0); PG8_MMA(1, 0, At, B0); PG8_BAR; PG8_SCHED;
            PG8_STAGE(PG8_SB(0, 1), b2 + hstep, voffB);
            PG8_WAIT_V(6); PG8_BAR; PG8_MMA(1, 1, At, B1); PG8_BAR;
            PG8_LDB(B0, 1, 0); PG8_SCHED; PG8_LDA(At, 1, 0); PG8_STAGE(PG8_SA(0, 1), a2 + hstep, voffA);
            PG8_WAIT_L(8); PG8_BAR; PG8_WAIT_L(0); PG8_MMA(0, 0, At, B0); PG8_BAR; PG8_SCHED;
            PG8_LDB(B1, 1, 1); PG8_STAGE(PG8_SB(1, 0), b3, voffB);
            PG8_BAR; PG8_WAIT_L(0); PG8_MMA(0, 1, At, B1); PG8_BAR;
            PG8_LDA(At, 1, 1); PG8_STAGE(PG8_SA(1, 0), a3, voffA);
            PG8_BAR; PG8_WAIT_L(0); PG8_MMA(1, 0, At, B0); PG8_BAR; PG8_SCHED;
            PG8_STAGE(PG8_SB(1, 1), b3 + hstep, voffB);
            PG8_WAIT_V(6); PG8_BAR; PG8_MMA(1, 1, At, B1); PG8_BAR;
            }
        }
        if constexpr (ALIGN_EPI) { if (wr == 0) PG8_BAR; }
        if constexpr (!Epi::AFTER_DRAIN) { E(acc, cur, wr, wc, fr, fq); S.done(cur); }
        if (!has_next) break;
#pragma unroll
        for (int a = 0; a < 2; ++a)
#pragma unroll
            for (int b = 0; b < 2; ++b)
#pragma unroll
                for (int m = 0; m < 4; ++m)
#pragma unroll
                    for (int n = 0; n < 2; ++n) acc[a][b][m][n] = (f32x4){0.f, 0.f, 0.f, 0.f};
        cur = nxt; cA = nA; cB = nB; ++ui;
        if constexpr (ALIGN_EPI) { if (wr == 1) PG8_BAR; }
    }
    PG8_WAIT_V(0);
    if constexpr (!ALIGN_EPI) { if (wr == 0) PG8_BAR; }
    PG8_BAR;
    if constexpr (Epi::AFTER_DRAIN) { E.fused(acc, cur, wr, wc, fr, fq, lds, wid, lane); S.done(cur); }
#undef PG8_SA
#undef PG8_SB
#undef PG8_STAGE
#undef PG8_LDA
#undef PG8_LDB
#undef PG8_MMA
#undef PG8_WAIT_V
#undef PG8_WAIT_L
#undef PG8_BAR
#undef PG8_SCHED
}
}

#ifndef PG8_SP2
#define PG8_SP2 true
#endif
#ifndef PG8_ALIGN
#define PG8_ALIGN true
#endif
#include <hip/hip_bf16.h>
#include <cmath>
namespace attn_body {
using bf16=__hip_bfloat16;
using bf16x8=__attribute__((ext_vector_type(8)))short;
using s16x4=__attribute__((ext_vector_type(4)))short;
using f32x16=__attribute__((ext_vector_type(16)))float;
using u32x4=__attribute__((ext_vector_type(4)))unsigned;
constexpr int BATCH=8,NHEAD=16,SEQ=2048,D=64,DM=NHEAD*D;
constexpr int NW=8,QBLK=32,QB=QBLK*NW,KVBLK=64,NQB=SEQ/QB;
constexpr int ATTN_PITCH=DM, ATTN_UNIT_ROWS=QB;
__device__ __forceinline__ int crow(int r,int hi){return (r&3)+8*(r>>2)+4*hi;}
#define SBAR() __builtin_amdgcn_sched_barrier(0)
__device__ __forceinline__ void cmask(f32x16&p0,f32x16&p1,int jb,int qrel,int hi){
  const float NEG=-INFINITY; int kb=64*jb+4*hi;
  #pragma unroll
  for(int r=0;r<16;++r){int kv=kb+(r&3)+8*(r>>2); if(kv>qrel)p0[r]=NEG; if(kv+32>qrel)p1[r]=NEG;}
}

constexpr int NSLOT=3, SLOTB=8192;
constexpr int LDS_K=0, LDS_V=NSLOT*SLOTB, LDS_WS=2*NSLOT*SLOTB, LDS_OST=LDS_WS+NW*64*4, LDS_BYTES=LDS_OST+NW*4096;
constexpr float C2=0.125f*1.4426950408889634f;
__device__ __forceinline__ void glds16(const void*gsrc,unsigned lds_dst){unsigned keep;
  asm volatile("s_mov_b32 %0, m0\n\ts_mov_b32 m0, %2\n\ts_nop 0\n\tglobal_load_lds_dwordx4 %1, off\n\ts_mov_b32 m0, %0":"=&s"(keep):"v"(gsrc),"s"(lds_dst):"memory");}
__device__ __forceinline__ float max3f(float a,float b,float c){float r;asm("v_max3_f32 %0, %1, %2, %3":"=v"(r):"v"(a),"v"(b),"v"(c));return r;}
__device__ __forceinline__ float max2f(float a,float b){float r;asm("v_max_f32_e32 %0, %1, %2":"=v"(r):"v"(a),"v"(b));return r;}
__device__ __forceinline__ float fadd_s(float a,float b){float r;asm("v_add_f32_e32 %0, %1, %2":"=v"(r):"v"(a),"v"(b));return r;}
__device__ __forceinline__ float fsub_s(float a,float b){float r;asm("v_sub_f32_e32 %0, %1, %2":"=v"(r):"v"(a),"v"(b));return r;}
typedef float f32x2_t __attribute__((ext_vector_type(2))); typedef __bf16 bf16x2_t __attribute__((ext_vector_type(2)));
__device__ __forceinline__ unsigned cvtpk_s(float lo,float hi){f32x2_t v={lo,hi};bf16x2_t b=__builtin_convertvector(v,bf16x2_t);return __builtin_bit_cast(unsigned,b);}
#define WAIT_BAR(N) asm volatile("s_waitcnt vmcnt(" #N ") lgkmcnt(0)\n\ts_barrier":::"memory")

__device__ __forceinline__ void qkt(f32x16&p0,f32x16&p1,const char*Kslot,const bf16x8*qr,const f32x16&negm,int r32,int hi){
  const char*kb=Kslot+hi*1024+r32*16;
  #pragma unroll
  for(int d0=0;d0<4;++d0){
    const bf16x8 b0=*reinterpret_cast<const bf16x8*>(kb+d0*2048);
    const bf16x8 b1=*reinterpret_cast<const bf16x8*>(kb+d0*2048+512);
    if(d0==0){p0=__builtin_amdgcn_mfma_f32_32x32x16_bf16(b0,qr[0],negm,0,0,0);p1=__builtin_amdgcn_mfma_f32_32x32x16_bf16(b1,qr[0],negm,0,0,0);}
    else{p0=__builtin_amdgcn_mfma_f32_32x32x16_bf16(b0,qr[d0],p0,0,0,0);p1=__builtin_amdgcn_mfma_f32_32x32x16_bf16(b1,qr[d0],p1,0,0,0);}}
}
typedef __attribute__((address_space(3))) const char* lds_cptr;
typedef short v4i16_t __attribute__((ext_vector_type(4)));
__device__ __forceinline__ void kload8(bf16x8*kf,lds_cptr kp){
  kf[0]=*(const __attribute__((address_space(3))) bf16x8*)(kp);      kf[1]=*(const __attribute__((address_space(3))) bf16x8*)(kp+512);
  kf[2]=*(const __attribute__((address_space(3))) bf16x8*)(kp+2048); kf[3]=*(const __attribute__((address_space(3))) bf16x8*)(kp+2560);
  kf[4]=*(const __attribute__((address_space(3))) bf16x8*)(kp+4096); kf[5]=*(const __attribute__((address_space(3))) bf16x8*)(kp+4608);
  kf[6]=*(const __attribute__((address_space(3))) bf16x8*)(kp+6144); kf[7]=*(const __attribute__((address_space(3))) bf16x8*)(kp+6656);
}
__device__ __forceinline__ void kload2(bf16x8*kf,lds_cptr kp,int j){ kf[2*j]=*(const __attribute__((address_space(3))) bf16x8*)(kp+j*2048); kf[2*j+1]=*(const __attribute__((address_space(3))) bf16x8*)(kp+j*2048+512); }
__device__ __forceinline__ s16x4 vtr(lds_cptr p){ return __builtin_bit_cast(s16x4,__builtin_amdgcn_ds_read_tr16_b64_v4i16((__attribute__((address_space(3))) v4i16_t*)p)); }
__device__ __forceinline__ float rowmax(const f32x16&p0,const f32x16&p1){
  float a=max3f(p0[0],p0[1],p1[0]),b=max3f(p0[2],p0[3],p1[1]);a=max3f(a,p1[2],p1[3]);
  #pragma unroll
  for(int r=4;r<16;r+=4){a=max3f(a,p0[r],p0[r+1]);b=max3f(b,p0[r+2],p0[r+3]);a=max3f(a,p1[r],p1[r+1]);b=max3f(b,p1[r+2],p1[r+3]);}
  const float m=max2f(a,b);
  auto rr=__builtin_amdgcn_permlane32_swap(__float_as_uint(m),__float_as_uint(m),false,false);
  return max2f(__uint_as_float(rr[0]),__uint_as_float(rr[1]));
}
__device__ __forceinline__ void pv(f32x16*o,int vb,bf16x8 pa0,bf16x8 pa1,bf16x8 pa2,bf16x8 pa3){
  #pragma unroll
  for(int d0=0;d0<2;++d0){s16x4 lo[4],hi[4];
    #pragma unroll
    for(int ks=0;ks<4;++ks){
      asm volatile("ds_read_b64_tr_b16 %0,%1 offset:%c2":"=&v"(lo[ks]):"v"(vb),"i"(d0*4096+ks*1024):"memory");
      asm volatile("ds_read_b64_tr_b16 %0,%1 offset:%c2":"=&v"(hi[ks]):"v"(vb),"i"(d0*4096+ks*1024+512):"memory");}
    asm volatile("s_waitcnt lgkmcnt(0)":::"memory");SBAR();
    #define PK(k) (bf16x8){lo[k][0],lo[k][1],lo[k][2],lo[k][3],hi[k][0],hi[k][1],hi[k][2],hi[k][3]}
    o[d0]=__builtin_amdgcn_mfma_f32_32x32x16_bf16(pa0,PK(0),o[d0],0,0,0);
    o[d0]=__builtin_amdgcn_mfma_f32_32x32x16_bf16(pa1,PK(1),o[d0],0,0,0);
    o[d0]=__builtin_amdgcn_mfma_f32_32x32x16_bf16(pa2,PK(2),o[d0],0,0,0);
    o[d0]=__builtin_amdgcn_mfma_f32_32x32x16_bf16(pa3,PK(3),o[d0],0,0,0);
    #undef PK
  }
}

#ifndef ATTN_STORE16
#define ATTN_STORE16(p,v) (*(u32x4*)(p)=(v))
#endif
template<int THRL> __device__ __forceinline__ void attn_unit(int b,int h,int hv,int qb,const bf16*Q,const bf16*__restrict__ K,const bf16*__restrict__ V,bf16*O,char*shm){
  int tid_=threadIdx.x; asm volatile("":"+v"(tid_)); const int tid=tid_,lane=tid&63,r32=lane&31,hi=lane>>5; const int wid=__builtin_amdgcn_readfirstlane(tid>>6);
  const long rowbase=(long)b*SEQ; const int q0=qb*QB;
  const bf16*Qw=Q+(rowbase+q0+wid*QBLK)*DM+h*D;
  const bf16*Kh=K+rowbase*DM+h*D,*Vh=V+rowbase*DM+hv*D;
  const unsigned lds0=(unsigned)(uintptr_t)shm;
  float*wsf=(float*)(shm+LDS_WS)+wid*64;
  const bf16*ksrc=Kh+(long)lane*DM+wid*8;
  const bf16*vsrc=Vh+(long)(16*(wid&3)+(lane>>2))*DM+(wid>>2)*32+(lane&3)*8;
  const unsigned kdst=lds0+LDS_K+wid*1024, vdst=lds0+LDS_V+wid*1024;
  #define DMA_K(t,slot) glds16(ksrc+(long)(t)*KVBLK*DM,(unsigned)__builtin_amdgcn_readfirstlane(kdst+(slot)))
  #define DMA_V(t,slot) glds16(vsrc+(long)(t)*KVBLK*DM,(unsigned)__builtin_amdgcn_readfirstlane(vdst+(slot)))
  const int vb0=(int)(lds0+LDS_V)+((lane>>4)&1)*32+(lane&3)*8+(4*hi+((lane&15)>>2))*64;
  const char*Kbase=shm+LDS_K; bf16x8 kf[8];
  const lds_cptr shm3=(lds_cptr)shm; const lds_cptr kp0=shm3+LDS_K+hi*1024+r32*16; const lds_cptr vp0=shm3+LDS_V+((lane>>4)&1)*32+(lane&3)*8+(4*hi+((lane&15)>>2))*64;
  const int NT=(q0+QB)/KVBLK;
  DMA_K(0,0);DMA_V(0,0);DMA_K(1,SLOTB);
  bf16x8 qr[4];
  #pragma unroll
  for(int d0=0;d0<4;++d0)qr[d0]=*reinterpret_cast<const bf16x8*>(&Qw[(long)r32*DM+d0*16+hi*8]);
  float mhat=0.f,l_reg=0.f;f32x16 o[2];o[0]=f32x16{};o[1]=f32x16{};f32x16 negm=f32x16{};asm volatile("":"+v"(negm));
  const int qrel=wid*QBLK+r32;
  #define CMASK(P0,P1,t) do{int jb_=(t)-(NT-4); if(jb_>=0)cmask(P0,P1,jb_,qrel,hi);}while(0)
  bool resc=false;
  #define START(P0,P1) do{ const float rm=rowmax(P0,P1); resc=false; \
    { const float dl=rm; mhat=fadd_s(mhat,dl); \
      _Pragma("unroll") for(int r=0;r<16;++r){P0[r]=fsub_s(P0[r],dl);P1[r]=fsub_s(P1[r],dl);} \
      _Pragma("unroll") for(int r=0;r<16;++r)negm[r]=-mhat; asm volatile("":"+v"(negm)); } \
    _Pragma("unroll") for(int r=0;r<16;++r)P0[r]=__builtin_amdgcn_exp2f(P0[r]); }while(0)
  #define RESC() do{ if(resc){ asm volatile("s_waitcnt lgkmcnt(0)":::"memory"); \
      _Pragma("unroll") for(int d_=0;d_<2;++d_) _Pragma("unroll") for(int r=0;r<16;++r)o[d_][r]*=wsf[crow(r,hi)]; } }while(0)
  f32x16 pA0,pA1,pB0,pB1;
  int sl_prev=0,sl_cur=0,sl_next=SLOTB;
  #define ROT() do{sl_prev=sl_cur;sl_cur=sl_next;sl_next=(sl_next==(NSLOT-1)*SLOTB)?0:sl_next+SLOTB;}while(0)
  DMA_K(2,2*SLOTB);
  WAIT_BAR(3);
  qkt(pA0,pA1,Kbase,qr,negm,r32,hi);asm volatile("s_nop 15\n\ts_nop 7":"+v"(pA0),"+v"(pA1));CMASK(pA0,pA1,0);
  START(pA0,pA1);
  _Pragma("unroll") for(int r=0;r<16;++r)pA1[r]=__builtin_amdgcn_exp2f(pA1[r]);
  WAIT_BAR(0);
  DMA_K(3,0);DMA_V(1,SLOTB);
  ROT();
  kload8(kf,kp0+sl_cur);
  WAIT_BAR(2);
  s16x4 vlo[8],vhi[8]; u32x4 pw0,pw1,pw2,pw3;
  #define PKW(P,B) cvtpk_s(P[B],P[B+1])
  #define PAF(k) __builtin_bit_cast(bf16x8,pw##k)
  #define VFR(i) (bf16x8){vlo[i][0],vlo[i][1],vlo[i][2],vlo[i][3],vhi[i][0],vhi[i][1],vhi[i][2],vhi[i][3]}
  #define PIN(x) asm volatile("":"+v"(x))
  #define MX3(a,b,c) __builtin_fmaxf(__builtin_fmaxf((a),(b)),(c))
  #define GAPA(MF,A0,A1,A2,A3,W0,W1,PW) do{ MF; sacc+=A0; sacc+=A1; sacc+=A2; sacc+=A3; PIN(sacc); W0; W1; PIN(PW); SBAR(); }while(0)
  #define EX(v) __builtin_amdgcn_exp2f(v)
  #define GAPB(MF,X,B) do{ MF; X[B]=EX(X[B]); X[B+1]=EX(X[B+1]); X[B+2]=EX(X[B+2]); X[B+3]=EX(X[B+3]); PIN(X); SBAR(); }while(0)
  #define VRD(i) do{ vlo[i]=vtr(vp_+(((i)>>2)*4096+((i)&3)*1024)); vhi[i]=vtr(vp_+(((i)>>2)*4096+((i)&3)*1024+512)); }while(0)
  #define KRD(G,j) do{ if(G){ kload2(kf,kp0+sl_next,j); SBAR(); } }while(0)
  #define STEP(C0,C1,P0,P1,t,GK,GV,GL) do{ SBAR(); \
    const lds_cptr vp_=vp0+sl_prev; \
    VRD(0); SBAR(); float sacc=(P0[0]+P0[1]); \
    GAPA(C0=__builtin_amdgcn_mfma_f32_32x32x16_bf16(kf[0],qr[0],negm,0,0,0), P0[2],P0[3],P0[4],P0[5],     pw0[0]=PKW(P0,0), pw0[1]=PKW(P0,2), pw0); \
    VRD(4); SBAR(); GAPA(C1=__builtin_amdgcn_mfma_f32_32x32x16_bf16(kf[1],qr[0],negm,0,0,0), P0[6],P0[7],P0[8],P0[9],     pw0[2]=PKW(P0,4), pw0[3]=PKW(P0,6), pw0); \
    VRD(1); SBAR(); GAPA(C0=__builtin_amdgcn_mfma_f32_32x32x16_bf16(kf[2],qr[1],C0,0,0,0),   P0[10],P0[11],P0[12],P0[13], pw1[0]=PKW(P0,8), pw1[1]=PKW(P0,10), pw1); \
    VRD(5); SBAR(); GAPA(C1=__builtin_amdgcn_mfma_f32_32x32x16_bf16(kf[3],qr[1],C1,0,0,0),   P0[14],P0[15],P1[0],P1[1],   pw1[2]=PKW(P0,12),pw1[3]=PKW(P0,14), pw1); \
    VRD(2); SBAR(); GAPA(C0=__builtin_amdgcn_mfma_f32_32x32x16_bf16(kf[4],qr[2],C0,0,0,0),   P1[2],P1[3],P1[4],P1[5],     pw2[0]=PKW(P1,0), pw2[1]=PKW(P1,2), pw2); \
    VRD(6); SBAR(); GAPA(C1=__builtin_amdgcn_mfma_f32_32x32x16_bf16(kf[5],qr[2],C1,0,0,0),   P1[6],P1[7],P1[8],P1[9],     pw2[2]=PKW(P1,4), pw2[3]=PKW(P1,6), pw2); \
    VRD(3); SBAR(); GAPA(C0=__builtin_amdgcn_mfma_f32_32x32x16_bf16(kf[6],qr[3],C0,0,0,0),   P1[10],P1[11],P1[12],P1[13], pw3[0]=PKW(P1,8), pw3[1]=PKW(P1,10), pw3); \
    VRD(7); SBAR(); GAPA(C1=__builtin_amdgcn_mfma_f32_32x32x16_bf16(kf[7],qr[3],C1,0,0,0),   P1[14],P1[15],0.f,0.f,       pw3[2]=PKW(P1,12),pw3[3]=PKW(P1,14), pw3); \
    l_reg+=sacc; \
    if(GK){DMA_K((t)+3,sl_cur);} if(GV){DMA_V((t)+1,sl_next);} \
    CMASK(C0,C1,t); \
    { float a=MX3(C0[0],C0[1],C1[0]),b=MX3(C0[2],C0[3],C1[1]); a=MX3(a,C1[2],C1[3]); \
      _Pragma("unroll") for(int r=4;r<16;r+=4){a=MX3(a,C0[r],C0[r+1]);b=MX3(b,C0[r+2],C0[r+3]);a=MX3(a,C1[r],C1[r+1]);b=MX3(b,C1[r+2],C1[r+3]);} \
      float rm=__builtin_fmaxf(a,b); { auto rr=__builtin_amdgcn_permlane32_swap(__float_as_uint(rm),__float_as_uint(rm),false,false); rm=__builtin_fmaxf(__uint_as_float(rr[0]),__uint_as_float(rr[1])); } \
      resc=false; \
      if(__builtin_expect(__any(rm>(float)THRL),0)){ const float dl=__builtin_fmaxf(rm,0.f); mhat+=dl; \
        _Pragma("unroll") for(int r=0;r<16;++r){C0[r]-=dl;C1[r]-=dl;} \
        _Pragma("unroll") for(int r=0;r<16;++r)negm[r]=-mhat; asm volatile("":"+v"(negm)); \
        const float f=__builtin_amdgcn_exp2f(-dl); l_reg*=f; if(hi==0)wsf[r32]=f; resc=true; } } \
    SBAR(); \
    GAPB(o[0]=__builtin_amdgcn_mfma_f32_32x32x16_bf16(PAF(0),VFR(0),o[0],0,0,0), C0,0); \
    GAPB(o[1]=__builtin_amdgcn_mfma_f32_32x32x16_bf16(PAF(0),VFR(4),o[1],0,0,0), C0,4); \
    KRD(GL,0); GAPB(o[0]=__builtin_amdgcn_mfma_f32_32x32x16_bf16(PAF(1),VFR(1),o[0],0,0,0), C0,8); \
    KRD(GL,1); GAPB(o[1]=__builtin_amdgcn_mfma_f32_32x32x16_bf16(PAF(1),VFR(5),o[1],0,0,0), C0,12); \
    KRD(GL,2); GAPB(o[0]=__builtin_amdgcn_mfma_f32_32x32x16_bf16(PAF(2),VFR(2),o[0],0,0,0), C1,0); \
    KRD(GL,3); GAPB(o[1]=__builtin_amdgcn_mfma_f32_32x32x16_bf16(PAF(2),VFR(6),o[1],0,0,0), C1,4); \
    GAPB(o[0]=__builtin_amdgcn_mfma_f32_32x32x16_bf16(PAF(3),VFR(3),o[0],0,0,0), C1,8); \
    GAPB(o[1]=__builtin_amdgcn_mfma_f32_32x32x16_bf16(PAF(3),VFR(7),o[1],0,0,0), C1,12); \
    }while(0)
  int t=1;
  #undef CMASK
  #define CMASK(P0,P1,t) do{}while(0)
  for(;t+5<NT;t+=2){
    STEP(pB0,pB1,pA0,pA1,t,true,true,true);     WAIT_BAR(2); RESC(); ROT();
    STEP(pA0,pA1,pB0,pB1,t+1,true,true,true);   WAIT_BAR(2); RESC(); ROT();
  }
  #undef CMASK
  #define CMASK(P0,P1,t) do{int jb_=(t)-(NT-4); if(jb_>=0)cmask(P0,P1,jb_,qrel,hi);}while(0)
  #define ENDW(tt) do{ if((tt)+3<NT){WAIT_BAR(2);} else if((tt)+2<NT){WAIT_BAR(1);} else {WAIT_BAR(0);} }while(0)
  for(;t+1<NT;t+=2){
    STEP(pB0,pB1,pA0,pA1,t,(t+3<NT),(t+1<NT),(t+1<NT));       ENDW(t);   RESC(); ROT();
    STEP(pA0,pA1,pB0,pB1,t+1,(t+4<NT),(t+2<NT),(t+2<NT));     ENDW(t+1); RESC(); ROT();
  }
  STEP(pB0,pB1,pA0,pA1,NT-1,false,false,false); RESC();
  { float sacc=pB0[0]+pB0[1]; _Pragma("unroll") for(int r=2;r<16;++r)sacc+=pB0[r]; _Pragma("unroll") for(int r=0;r<16;++r)sacc+=pB1[r]; l_reg+=sacc;
    pw0=(u32x4){PKW(pB0,0),PKW(pB0,2),PKW(pB0,4),PKW(pB0,6)};pw1=(u32x4){PKW(pB0,8),PKW(pB0,10),PKW(pB0,12),PKW(pB0,14)};pw2=(u32x4){PKW(pB1,0),PKW(pB1,2),PKW(pB1,4),PKW(pB1,6)};pw3=(u32x4){PKW(pB1,8),PKW(pB1,10),PKW(pB1,12),PKW(pB1,14)};
    SBAR(); pv(o,vb0+sl_cur,PAF(0),PAF(1),PAF(2),PAF(3)); }
  #undef PKW
  #undef PAF
  #undef VFR
  #undef PIN
  #undef MX3
  #undef GAPA
  #undef GAPB
  #undef EX
  #undef VRD
  #undef KRD
  #undef STEP
  #undef ENDW
  {auto rr=__builtin_amdgcn_permlane32_swap(__float_as_uint(l_reg),__float_as_uint(l_reg),false,false);l_reg=__uint_as_float(rr[0])+__uint_as_float(rr[1]);}
  if(hi==0)wsf[32+r32]=l_reg;asm volatile("s_waitcnt lgkmcnt(0)":::"memory");
  float rli[16];
  #pragma unroll
  for(int r=0;r<16;++r)rli[r]=__builtin_amdgcn_rcpf(wsf[32+crow(r,hi)]);
  bf16*Ow=O+(rowbase+q0+wid*QBLK)*DM+hv*D;
  { bf16*stg=(bf16*)(shm+LDS_OST)+wid*2048;
    #pragma unroll
    for(int r=0;r<16;++r){const int orow=crow(r,hi);
      #pragma unroll
      for(int d0=0;d0<2;++d0)stg[orow*64+d0*32+r32]=__float2bfloat16(o[d0][r]*rli[r]);}
    asm volatile("s_waitcnt lgkmcnt(0)":::"memory");
    #pragma unroll
    for(int i=0;i<4;++i){const int row=i*8+(lane>>3),ch=lane&7; const u32x4 v=*(const u32x4*)(stg+row*64+ch*8); ATTN_STORE16(Ow+(long)row*DM+ch*8,v);} }
  asm volatile("s_waitcnt lgkmcnt(0)\n\ts_barrier":::"memory");
  #undef DMA_K
  #undef DMA_V
  #undef CMASK
  #undef START
  #undef RESC
  #undef ROT
}
constexpr int ATTN_LDS_BYTES=LDS_BYTES;
#undef SBAR
#undef WAIT_BAR
}
#include <hip/hip_cooperative_groups.h>
namespace cg = cooperative_groups;
#define LAS __attribute__((address_space(3)))
typedef unsigned short bf16;
typedef unsigned v4u __attribute__((ext_vector_type(4)));
typedef unsigned v2u __attribute__((ext_vector_type(2)));
typedef float f32x4 __attribute__((ext_vector_type(4)));
typedef short bf16x8 __attribute__((ext_vector_type(8)));

constexpr int M = 16384, DM = 2048, DFF = 5632, SEQ = 2048, NB = 8;
constexpr int NPROJ = 7168;
constexpr float EPS = 1e-6f;
constexpr float LOG2E = 1.4426950408889634f;
constexpr size_t MiB = 1u << 20;
constexpr size_t WS_ROPE = 0;
constexpr size_t WS_BAR = 256 * 1024, WS_BAR_BYTES = 16384;
constexpr size_t WS_SS = 320 * 1024;
constexpr size_t WS_CNT = 576 * 1024;
constexpr size_t WS_ZERO_BYTES = 336 * 1024;
constexpr size_t WS_WFI = 1 * MiB;
constexpr size_t WS_WFO = 45 * MiB;
constexpr size_t WS_WIN = 67 * MiB;
constexpr size_t WS_WPA = 111 * MiB, WS_WPR = 115 * MiB, WS_WWO = 119 * MiB;
constexpr size_t WS_H = 127 * MiB;
constexpr size_t WS_BIG = 191 * MiB;
constexpr size_t WS_Y = 415 * MiB;
constexpr size_t WS_OR = 479 * MiB;
constexpr size_t WS_END = 511 * MiB;
constexpr size_t PBUF = (size_t)M * 1024;
enum { PB_QA = 0, PB_KA = 1, PB_VA = 2, PB_QR = 3, PB_LF = 4, PB_IO = 5, PB_G = 6 };
constexpr int RING_BYTES = 131072, LDS_BYTES = 147456;

__device__ __forceinline__ float fexp(float x) { return __builtin_amdgcn_exp2f(x * LOG2E); }
__device__ __forceinline__ float sigm(float x) { return __builtin_amdgcn_rcpf(1.f + fexp(-x)); }
__device__ __forceinline__ float silu(float x) { return x * sigm(x); }
typedef float f32x2_m __attribute__((ext_vector_type(2))); typedef __bf16 bf16x2_m __attribute__((ext_vector_type(2)));
__device__ __forceinline__ unsigned pkbf(float lo, float hi) { const f32x2_m v = {lo, hi}; const bf16x2_m b = __builtin_convertvector(v, bf16x2_m); return __builtin_bit_cast(unsigned, b); }
__device__ __forceinline__ float bflo(unsigned w) { return __builtin_bit_cast(float, w << 16); }
__device__ __forceinline__ float bfhi(unsigned w) { return __builtin_bit_cast(float, w & 0xffff0000u); }
__device__ __forceinline__ unsigned pkh(float lo, float hi) { const _Float16 a = (_Float16)lo, b = (_Float16)hi; return (unsigned)__builtin_bit_cast(unsigned short, a) | ((unsigned)__builtin_bit_cast(unsigned short, b) << 16); }
__device__ __forceinline__ float wave_sum(float v) {
#pragma unroll
    for (int o = 1; o < 64; o <<= 1) v += __shfl_xor(v, o);
    return v;
}

namespace epi {
using pg8::Unit; using pg8::BM; using pg8::HALF;
template <int RSM> __device__ __forceinline__ float row_scale(const float* p, int row) { const float v = __hip_atomic_load(p + row, __ATOMIC_RELAXED, __HIP_MEMORY_SCOPE_AGENT); return RSM == 0 ? v : 1.0f / sqrtf(v * (1.f / DM) + EPS); }
template <int RSM> struct EpiSwiglu { static constexpr bool PERM = true, AFTER_DRAIN = false; bf16* O; int ldc; const float* rs;
    __device__ __forceinline__ void operator()(const f32x4 (&acc)[2][2][4][2], const Unit& u, int wr, int wc, int fr, int fq) const {
        const int row0 = u.pm * BM + wr * 64 + fr, col0 = u.pn * HALF + wc * 32 + 8 * fq;
#pragma unroll
        for (int ai = 0; ai < 2; ++ai)
#pragma unroll
            for (int m = 0; m < 4; ++m) { const int row = row0 + ai * HALF + m * 16; bf16* rowp = O + (size_t)row * ldc + col0; const float sc = row_scale<RSM>(rs, row);
                const f32x4 g0 = acc[ai][0][m][0] * sc, g1 = acc[ai][0][m][1] * sc, u0 = acc[ai][1][m][0] * sc, u1 = acc[ai][1][m][1] * sc;
                v4u w; w.x = pkbf(silu(g0[0]) * u0[0], silu(g0[1]) * u0[1]); w.y = pkbf(silu(g0[2]) * u0[2], silu(g0[3]) * u0[3]);
                w.z = pkbf(silu(g1[0]) * u1[0], silu(g1[1]) * u1[1]); w.w = pkbf(silu(g1[2]) * u1[2], silu(g1[3]) * u1[3]);
                __builtin_nontemporal_store(w, (v4u*)rowp); }
    }
};
template <int NORM, int SSI, bool HALFSC> struct EpiResid { static constexpr bool PERM = false, AFTER_DRAIN = false; static constexpr int ldc = DM; const float* base; float* out; unsigned char* wsb;
    __device__ __forceinline__ void operator()(const f32x4 (&acc)[2][2][4][2], const Unit& u, int wr, int wc, int fr, int fq) const {
        const int row0 = u.pm * BM + wr * 64 + fr, col0 = u.pn * BM + wc * 32 + 4 * fq; const float scale = HALFSC ? 0.5f : 1.0f;
        bf16* xb = (bf16*)(wsb + WS_H); float* ss = (float*)(wsb + WS_SS) + (size_t)SSI * M;
#pragma unroll
        for (int ai = 0; ai < 2; ++ai) { f32x4 pre[4][2][2];
#pragma unroll
            for (int m = 0; m < 4; ++m)
#pragma unroll
                for (int bj = 0; bj < 2; ++bj)
#pragma unroll
                    for (int n = 0; n < 2; ++n) pre[m][bj][n] = *(const f32x4*)(base + (size_t)(row0 + ai * HALF + m * 16) * ldc + col0 + bj * HALF + n * 16);
            asm volatile("" ::: "memory");
#pragma unroll
            for (int m = 0; m < 4; ++m) { const int row = row0 + ai * HALF + m * 16; const size_t off = (size_t)row * ldc + col0; float sq = 0.f;
#pragma unroll
                for (int bj = 0; bj < 2; ++bj)
#pragma unroll
                    for (int n = 0; n < 2; ++n) { const size_t p = off + bj * HALF + n * 16; const f32x4 o = pre[m][bj][n] + acc[ai][bj][m][n] * scale; *(f32x4*)(out + p) = o;
                        if (NORM == 1) *(v2u*)(xb + p) = (v2u){pkbf(o[0], o[1]), pkbf(o[2], o[3])};
                        if (NORM) sq += (o[0] * o[0] + o[1] * o[1]) + (o[2] * o[2] + o[3] * o[3]); }
                if (NORM) { sq += __shfl_xor(sq, 16); sq += __shfl_xor(sq, 32); if (fq == 0) __hip_atomic_fetch_add(ss + row, sq, __ATOMIC_RELAXED, __HIP_MEMORY_SCOPE_AGENT); } } }
    }
};
template <int MODE> struct EpiGate { static constexpr bool PERM = true, AFTER_DRAIN = false; bf16* T1; const unsigned char* gt;
    __device__ __forceinline__ void operator()(const f32x4 (&acc)[2][2][4][2], const Unit& u, int wr, int wc, int fr, int fq) const {
        const int row0 = u.pm * BM + wr * 64 + fr, col0 = u.pn * BM + wc * 32 + 8 * fq;
#pragma unroll
        for (int ai = 0; ai < 2; ++ai) { v2u gq[4][2]; v4u tq[4][2];
#pragma unroll
            for (int m = 0; m < 4; ++m)
#pragma unroll
                for (int bj = 0; bj < 2; ++bj) { const size_t p = (size_t)(row0 + ai * HALF + m * 16) * DM + col0 + bj * HALF; gq[m][bj] = *(const v2u*)(gt + p); if (MODE == 1) tq[m][bj] = *(const v4u*)(T1 + p); }
            asm volatile("" ::: "memory");
#pragma unroll
            for (int m = 0; m < 4; ++m)
#pragma unroll
                for (int bj = 0; bj < 2; ++bj) { const size_t p = (size_t)(row0 + ai * HALF + m * 16) * DM + col0 + bj * HALF;
                    const f32x4 a0 = acc[ai][bj][m][0], a1 = acc[ai][bj][m][1]; const v2u g = gq[m][bj]; const float s = 1.f / 255.f;
                    float v[8] = {a0[0] * ((float)((g.x >> 0) & 0xffu) * s), a0[1] * ((float)((g.x >> 8) & 0xffu) * s), a0[2] * ((float)((g.x >> 16) & 0xffu) * s), a0[3] * ((float)((g.x >> 24) & 0xffu) * s),
                                  a1[0] * ((float)((g.y >> 0) & 0xffu) * s), a1[1] * ((float)((g.y >> 8) & 0xffu) * s), a1[2] * ((float)((g.y >> 16) & 0xffu) * s), a1[3] * ((float)((g.y >> 24) & 0xffu) * s)};
                    if (MODE == 1) { const v4u t = tq[m][bj];
                        v[0] += bflo(t.x); v[1] += bfhi(t.x); v[2] += bflo(t.y); v[3] += bfhi(t.y); v[4] += bflo(t.z); v[5] += bfhi(t.z); v[6] += bflo(t.w); v[7] += bfhi(t.w); }
                    v4u w; w.x = pkbf(v[0], v[1]); w.y = pkbf(v[2], v[3]); w.z = pkbf(v[4], v[5]); w.w = pkbf(v[6], v[7]);
                    *(v4u*)(T1 + p) = w; } }
    }
};
struct EpiMix { static constexpr bool PERM = true, AFTER_DRAIN = false; unsigned char* wsb; const float* lbraw;
    __device__ __forceinline__ void operator()(const f32x4 (&acc)[2][2][4][2], const Unit& u, int wr, int wc, int fr, int fq) const {
        bf16* P = (bf16*)(wsb + WS_BIG); const float* ropeC = (const float*)(wsb + WS_ROPE); const float* ropeS = ropeC + SEQ * 8; const float* rs = (const float*)(wsb + WS_SS) + M;
        const int reg = u.pn >> 2; bf16* base = P + (size_t)reg * PBUF;
        const int row0 = u.pm * BM + wr * 64 + fr, lc0 = (u.pn & 3) * 256 + wc * 32 + 8 * fq;
        const bool rope = (reg <= 1) && ((wc & 1) == 0);
        const float qs = (reg == 0) ? attn_body::C2 : 1.f;
        float lb[2][8];
        if (reg == PB_LF) {
#pragma unroll
            for (int bj = 0; bj < 2; ++bj)
#pragma unroll
                for (int j = 0; j < 8; ++j) { const int c = lc0 + bj * HALF + j; lb[bj][j] = sigm(lbraw[c] - lbraw[1024 + c]); }
        }
#pragma unroll
        for (int ai = 0; ai < 2; ++ai)
#pragma unroll
            for (int m = 0; m < 4; ++m) { const int row = row0 + ai * HALF + m * 16; const float sc = row_scale<1>(rs, row);
                f32x4 c0, c1, s0, s1;
                if (rope) { const int pos = row & (SEQ - 1); c0 = *(const f32x4*)(ropeC + pos * 8); c1 = *(const f32x4*)(ropeC + pos * 8 + 4); s0 = *(const f32x4*)(ropeS + pos * 8); s1 = *(const f32x4*)(ropeS + pos * 8 + 4); }
#pragma unroll
                for (int bj = 0; bj < 2; ++bj) { const f32x4 a0 = acc[ai][bj][m][0] * sc, a1 = acc[ai][bj][m][1] * sc;
                    float v[8] = {a0[0], a0[1], a0[2], a0[3], a1[0], a1[1], a1[2], a1[3]};
                    v4u w;
                    if (reg >= 7) {
                        unsigned g0 = 0u, g1 = 0u;
                        g0 = __builtin_amdgcn_cvt_pk_u8_f32(__builtin_rintf(sigm(v[0]) * 255.f), 0, g0); g0 = __builtin_amdgcn_cvt_pk_u8_f32(__builtin_rintf(sigm(v[1]) * 255.f), 1, g0);
                        g0 = __builtin_amdgcn_cvt_pk_u8_f32(__builtin_rintf(sigm(v[2]) * 255.f), 2, g0); g0 = __builtin_amdgcn_cvt_pk_u8_f32(__builtin_rintf(sigm(v[3]) * 255.f), 3, g0);
                        g1 = __builtin_amdgcn_cvt_pk_u8_f32(__builtin_rintf(sigm(v[4]) * 255.f), 0, g1); g1 = __builtin_amdgcn_cvt_pk_u8_f32(__builtin_rintf(sigm(v[5]) * 255.f), 1, g1);
                        g1 = __builtin_amdgcn_cvt_pk_u8_f32(__builtin_rintf(sigm(v[6]) * 255.f), 2, g1); g1 = __builtin_amdgcn_cvt_pk_u8_f32(__builtin_rintf(sigm(v[7]) * 255.f), 3, g1);
                        unsigned char* gb = wsb + WS_WFI + (reg >= 9 ? (size_t)M * DM : (size_t)0);
                        *(v2u*)(gb + (size_t)row * DM + ((u.pn - 28) & 7) * 256 + wc * 32 + 8 * fq + bj * HALF) = (v2u){g0, g1};
                        continue; }
                    if (reg <= 1) {
                        if (rope) { const float cs[8] = {c0[0], c0[1], c0[2], c0[3], c1[0], c1[1], c1[2], c1[3]}; const float sn[8] = {s0[0], s0[1], s0[2], s0[3], s1[0], s1[1], s1[2], s1[3]};
#pragma unroll
                            for (int j = 0; j < 8; ++j) { const float o = __shfl_xor(v[j], 16); if (fq == 0) v[j] = v[j] * cs[j] - o * sn[j]; else if (fq == 1) v[j] = v[j] * cs[j] + o * sn[j]; } }
#pragma unroll
                        for (int j = 0; j < 8; ++j) v[j] *= qs;
                    } else if (reg == PB_QR || reg == PB_G) {
#pragma unroll
                        for (int j = 0; j < 8; ++j) v[j] = silu(v[j]);
                    }
                    if (reg == PB_LF) {
#pragma unroll
                        for (int j = 0; j < 8; ++j) v[j] = (1.f - lb[bj][j]) * sigm(-v[j]);
                        w.x = pkh(v[0], v[1]); w.y = pkh(v[2], v[3]); w.z = pkh(v[4], v[5]); w.w = pkh(v[6], v[7]);
                    } else { w.x = pkbf(v[0], v[1]); w.y = pkbf(v[2], v[3]); w.z = pkbf(v[4], v[5]); w.w = pkbf(v[6], v[7]); }
                    *(v4u*)(base + (size_t)row * 1024 + lc0 + bj * HALF) = w; } }
    }
};
struct EpiFinal { static constexpr bool PERM = false, AFTER_DRAIN = false; static constexpr int ldc = DM; float* out; unsigned char* wsb; const float* wfin;
    __device__ __forceinline__ void operator()(f32x4 (&acc)[2][2][4][2], const Unit& u, int wr, int wc, int fr, int fq) const {
        const int row0 = u.pm * BM + wr * 64 + fr, col0 = u.pn * BM + wc * 32 + 4 * fq;
        float* ss = (float*)(wsb + WS_SS) + (size_t)3 * M; unsigned* cnt = (unsigned*)(wsb + WS_CNT) + 64 * u.pm;
#pragma unroll
        for (int ai = 0; ai < 2; ++ai) { f32x4 pre[4][2][2];
#pragma unroll
            for (int m = 0; m < 4; ++m)
#pragma unroll
                for (int bj = 0; bj < 2; ++bj)
#pragma unroll
                    for (int n = 0; n < 2; ++n) pre[m][bj][n] = *(const f32x4*)(out + (size_t)(row0 + ai * HALF + m * 16) * ldc + col0 + bj * HALF + n * 16);
            asm volatile("" ::: "memory");
#pragma unroll
            for (int m = 0; m < 4; ++m) { const int row = row0 + ai * HALF + m * 16; float sq = 0.f;
#pragma unroll
                for (int bj = 0; bj < 2; ++bj)
#pragma unroll
                    for (int n = 0; n < 2; ++n) { const f32x4 o = pre[m][bj][n] + acc[ai][bj][m][n] * 0.5f; acc[ai][bj][m][n] = o;
                        sq += (o[0] * o[0] + o[1] * o[1]) + (o[2] * o[2] + o[3] * o[3]); }
                sq += __shfl_xor(sq, 16); sq += __shfl_xor(sq, 32); if (fq == 0) __hip_atomic_fetch_add(ss + row, sq, __ATOMIC_RELAXED, __HIP_MEMORY_SCOPE_AGENT); } }
        asm volatile("s_waitcnt vmcnt(0)" ::: "memory");
        if (fr == 0 && fq == 0) { __hip_atomic_fetch_add(cnt, 1u, __ATOMIC_RELAXED, __HIP_MEMORY_SCOPE_AGENT);
            unsigned spins = 0; while (__hip_atomic_load(cnt, __ATOMIC_RELAXED, __HIP_MEMORY_SCOPE_AGENT) < 64u && ++spins < (1u << 22)) __builtin_amdgcn_s_sleep(2); }
        asm volatile("" ::: "memory");
#pragma unroll
        for (int ai = 0; ai < 2; ++ai)
#pragma unroll
            for (int m = 0; m < 4; ++m) { const int row = row0 + ai * HALF + m * 16; const size_t off = (size_t)row * ldc + col0; const float rs = row_scale<1>(ss, row);
#pragma unroll
                for (int bj = 0; bj < 2; ++bj)
#pragma unroll
                    for (int n = 0; n < 2; ++n) { const size_t p = off + bj * HALF + n * 16; const f32x4 w4 = *(const f32x4*)(wfin + col0 + bj * HALF + n * 16); *(f32x4*)(out + p) = acc[ai][bj][m][n] * rs * w4; } }
    }
};
struct PanelOrder { int v;
    __host__ __device__ bool next(int i, Unit& u) const { if (i >= 2) return false; u.pm = 8 * (v >> 5) + 4 * i + ((v >> 3) & 3); u.pn = v & 7; return true; }
    __device__ __forceinline__ void a_ready(const Unit&) const {}
    __device__ __forceinline__ void done(const Unit&) const {}
};
}

namespace hg {
constexpr int QS = 136, TS = 72;
constexpr int OFF_QG = 0, OFF_KN = 17408, OFF_KLT = 34816, OFF_VT = 53248, OFF_AM = 57856, OFF_ST = 67072, OFF_TOT = 75776, OFF_GL = 77824, HG_LDS = 78336;
#define HG_MFMA(x, y, c) __builtin_amdgcn_mfma_f32_16x16x32_bf16((x), (y), (c), 0, 0, 0)
#define HG_LD8(off) (*(const LAS bf16x8*)(lds + (off)))
#define HG_BAR() asm volatile("s_waitcnt lgkmcnt(0)\n\ts_barrier" ::: "memory")
__device__ __forceinline__ void hgrn_unit(LAS unsigned char* lds, int b, int h, int vs, const bf16* QR, const _Float16* LF, const bf16* IO, bf16* OR_) {
    int tid_ = threadIdx.x; asm volatile("" : "+v"(tid_));
    const int tid = tid_, lane = tid & 63, wid = __builtin_amdgcn_readfirstlane(tid >> 6), fr = lane & 15, fq = lane >> 4;
    const size_t rowbase = (size_t)b * SEQ;
    constexpr int NCH = SEQ / 64;
    if (wid < 4) {
        const int ew = wid, t0 = 16 * ew;
        const unsigned* lp = (const unsigned*)(LF + (rowbase + t0) * 1024 + h * 128) + lane;
        const unsigned* qp = (const unsigned*)(QR + (rowbase + t0) * 1024 + h * 128) + lane;
        const int et = ew * 64 + lane, vrow = et >> 2, c8 = et & 3;
        const v4u* vp = (const v4u*)(IO + (rowbase + vrow) * 1024 + h * 128 + vs * 32 + 8 * c8);
        unsigned clf[16], cq[16], nlf[16], nq[16]; v4u cv, nv;
#pragma unroll
        for (int i = 0; i < 16; ++i) { clf[i] = lp[i * 512]; cq[i] = qp[i * 512]; nlf[i] = 0u; nq[i] = 0u; }
        cv = *vp; nv = cv;
        for (int n = 0; n < NCH; ++n) {
            if (n + 1 < NCH) { lp += 64 * 512; qp += 64 * 512; vp += 64 * 128;
#pragma unroll
                for (int i = 0; i < 16; ++i) { nlf[i] = lp[i * 512]; nq[i] = qp[i * 512]; }
                nv = *vp; }
            float qa[2][16], kb[2][16], tot[2];
#pragma unroll
            for (int e = 0; e < 2; ++e) { float run = 1.f;
#pragma unroll
                for (int i = 0; i < 16; ++i) { const unsigned short hb = (unsigned short)(e ? (clf[i] >> 16) : (clf[i] & 0xffffu)); const float kk = (float)__builtin_bit_cast(_Float16, hb);
                    run *= (1.f - kk); const float q = e ? bfhi(cq[i]) : bflo(cq[i]);
                    qa[e][i] = q * run; kb[e][i] = kk * __builtin_amdgcn_rcpf(run); }
                tot[e] = run; }
            ((LAS f32x2_m*)(lds + OFF_TOT))[ew * 64 + lane] = (f32x2_m){tot[0], tot[1]};
            HG_BAR();
            float eoff[2], ieoff[2], eGl[2];
            { const f32x2_m t0v = ((LAS f32x2_m*)(lds + OFF_TOT))[lane], t1v = ((LAS f32x2_m*)(lds + OFF_TOT))[64 + lane], t2v = ((LAS f32x2_m*)(lds + OFF_TOT))[128 + lane], t3v = ((LAS f32x2_m*)(lds + OFF_TOT))[192 + lane];
#pragma unroll
              for (int e = 0; e < 2; ++e) { const float off = (ew > 0 ? t0v[e] : 1.f) * (ew > 1 ? t1v[e] : 1.f) * (ew > 2 ? t2v[e] : 1.f);
                  eoff[e] = off; ieoff[e] = __builtin_amdgcn_rcpf(off); eGl[e] = (t0v[e] * t1v[e]) * (t2v[e] * t3v[e]); } }
            unsigned klp[2][8];
#pragma unroll
            for (int i = 0; i < 16; i += 2) { float kl[2][2];
#pragma unroll
                for (int d = 0; d < 2; ++d) { const float kn0 = kb[0][i + d] * ieoff[0], kn1 = kb[1][i + d] * ieoff[1];
                    ((LAS unsigned*)(lds + OFF_QG))[(t0 + i + d) * (QS / 2) + lane] = pkbf(qa[0][i + d] * eoff[0], qa[1][i + d] * eoff[1]);
                    ((LAS unsigned*)(lds + OFF_KN))[(t0 + i + d) * (QS / 2) + lane] = pkbf(kn0, kn1);
                    kl[0][d] = kn0 * eGl[0]; kl[1][d] = kn1 * eGl[1]; }
                klp[0][i >> 1] = pkbf(kl[0][0], kl[0][1]); klp[1][i >> 1] = pkbf(kl[1][0], kl[1][1]); }
#pragma unroll
            for (int e = 0; e < 2; ++e) { const int k = 2 * lane + e;
                *(LAS v4u*)(lds + OFF_KLT + (k * TS + t0) * 2) = (v4u){klp[e][0], klp[e][1], klp[e][2], klp[e][3]};
                *(LAS v4u*)(lds + OFF_KLT + (k * TS + t0 + 8) * 2) = (v4u){klp[e][4], klp[e][5], klp[e][6], klp[e][7]}; }
            if (ew == 0) ((LAS f32x2_m*)(lds + OFF_GL))[lane] = (f32x2_m){eGl[0], eGl[1]};
            { LAS bf16* vt = (LAS bf16*)(lds + OFF_VT) + (8 * c8) * TS + vrow;
              vt[0 * TS] = (bf16)(cv.x & 0xffffu); vt[1 * TS] = (bf16)(cv.x >> 16); vt[2 * TS] = (bf16)(cv.y & 0xffffu); vt[3 * TS] = (bf16)(cv.y >> 16);
              vt[4 * TS] = (bf16)(cv.z & 0xffffu); vt[5 * TS] = (bf16)(cv.z >> 16); vt[6 * TS] = (bf16)(cv.w & 0xffffu); vt[7 * TS] = (bf16)(cv.w >> 16); }
#pragma unroll
            for (int i = 0; i < 16; ++i) { clf[i] = nlf[i]; cq[i] = nq[i]; }
            cv = nv;
            HG_BAR();
        }
        HG_BAR(); HG_BAR();
    } else {
        const int mw = wid - 4;
        for (int i = tid - 256; i < 32 * QS / 2; i += 256) ((LAS unsigned*)(lds + OFF_ST))[i] = 0u;
        f32x4 sacc[2][2];
#pragma unroll
        for (int ki = 0; ki < 2; ++ki)
#pragma unroll
            for (int vj = 0; vj < 2; ++vj) sacc[ki][vj] = (f32x4){0.f, 0.f, 0.f, 0.f};
        bf16* op = OR_ + (rowbase + 16 * mw + fr) * 1024 + h * 128 + vs * 32 + 4 * fq;
        HG_BAR(); HG_BAR();
        for (int c = 0; c < NCH; ++c) {
            bf16x8 qgf[4], knf[4][4], stf[2][4], vtf[2][2], klf[2][2]; f32x4 glv[2];
#pragma unroll
            for (int kk = 0; kk < 4; ++kk) qgf[kk] = HG_LD8(OFF_QG + ((16 * mw + fr) * QS + 32 * kk + 8 * fq) * 2);
#pragma unroll
            for (int sj = 0; sj < 4; ++sj)
#pragma unroll
                for (int kk = 0; kk < 4; ++kk) knf[sj][kk] = (sj <= mw) ? HG_LD8(OFF_KN + ((16 * sj + fr) * QS + 32 * kk + 8 * fq) * 2) : qgf[kk];
#pragma unroll
            for (int vj = 0; vj < 2; ++vj) {
#pragma unroll
                for (int kk = 0; kk < 4; ++kk) stf[vj][kk] = HG_LD8(OFF_ST + ((16 * vj + fr) * QS + 32 * kk + 8 * fq) * 2);
#pragma unroll
                for (int ss = 0; ss < 2; ++ss) vtf[vj][ss] = HG_LD8(OFF_VT + ((16 * vj + fr) * TS + 32 * ss + 8 * fq) * 2); }
#pragma unroll
            for (int ki = 0; ki < 2; ++ki) { const int kg = 2 * mw + ki; glv[ki] = *(const LAS f32x4*)(lds + OFF_GL + (16 * kg + 4 * fq) * 4);
#pragma unroll
                for (int ss = 0; ss < 2; ++ss) klf[ki][ss] = HG_LD8(OFF_KLT + ((16 * kg + fr) * TS + 32 * ss + 8 * fq) * 2); }
            f32x4 a[4], o[2];
#pragma unroll
            for (int sj = 0; sj < 4; ++sj) { a[sj] = (f32x4){0.f, 0.f, 0.f, 0.f};
                if (sj <= mw) {
#pragma unroll
                    for (int kk = 0; kk < 4; ++kk) a[sj] = HG_MFMA(knf[sj][kk], qgf[kk], a[sj]);
                    if (sj == mw) {
#pragma unroll
                        for (int r = 0; r < 4; ++r) if (4 * fq + r > fr) a[sj][r] = 0.f; }
                } }
#pragma unroll
            for (int vj = 0; vj < 2; ++vj) { o[vj] = (f32x4){0.f, 0.f, 0.f, 0.f};
#pragma unroll
                for (int kk = 0; kk < 4; ++kk) o[vj] = HG_MFMA(stf[vj][kk], qgf[kk], o[vj]); }
#pragma unroll
            for (int ki = 0; ki < 2; ++ki)
#pragma unroll
                for (int vj = 0; vj < 2; ++vj) { sacc[ki][vj] = sacc[ki][vj] * glv[ki]; sacc[ki][vj] = HG_MFMA(klf[ki][0], vtf[vj][0], sacc[ki][vj]); sacc[ki][vj] = HG_MFMA(klf[ki][1], vtf[vj][1], sacc[ki][vj]); }
#pragma unroll
            for (int sj = 0; sj < 4; ++sj) *(LAS v2u*)(lds + OFF_AM + ((16 * mw + fr) * TS + 16 * sj + 4 * fq) * 2) = (v2u){pkbf(a[sj][0], a[sj][1]), pkbf(a[sj][2], a[sj][3])};
            HG_BAR();
            bf16x8 amf[2];
#pragma unroll
            for (int ss = 0; ss < 2; ++ss) amf[ss] = HG_LD8(OFF_AM + ((16 * mw + fr) * TS + 32 * ss + 8 * fq) * 2);
#pragma unroll
            for (int ki = 0; ki < 2; ++ki)
#pragma unroll
                for (int vj = 0; vj < 2; ++vj) *(LAS v2u*)(lds + OFF_ST + ((16 * vj + fr) * QS + 16 * (2 * mw + ki) + 4 * fq) * 2) = (v2u){pkbf(sacc[ki][vj][0], sacc[ki][vj][1]), pkbf(sacc[ki][vj][2], sacc[ki][vj][3])};
#pragma unroll
            for (int vj = 0; vj < 2; ++vj) {
#pragma unroll
                for (int ss = 0; ss < 2; ++ss) if (32 * ss <= 16 * mw + 15) o[vj] = HG_MFMA(vtf[vj][ss], amf[ss], o[vj]);
                *(v2u*)(op + (size_t)c * 64 * 1024 + 16 * vj) = (v2u){pkbf(o[vj][0], o[vj][1]), pkbf(o[vj][2], o[vj][3])}; }
            HG_BAR();
        }
    }
}
#undef HG_MFMA
#undef HG_LD8
}

__device__ __forceinline__ void tr_item(const float* W, const float* nw, int K, int N, bf16* WT, int k0, int n0, int drow0, LAS float* scr, int lane) {
    { const int r = lane >> 3, c4 = lane & 7; f32x4 v[8];
#pragma unroll
      for (int i = 0; i < 8; ++i) v[i] = *(const f32x4*)(W + (size_t)(k0 + 8 * i + r) * N + n0 + 4 * c4);
#pragma unroll
      for (int i = 0; i < 8; ++i) { LAS float* d = scr + (8 * i + r) * 33 + 4 * c4; const float s = nw ? nw[k0 + 8 * i + r] : 1.f; d[0] = v[i].x * s; d[1] = v[i].y * s; d[2] = v[i].z * s; d[3] = v[i].w * s; } }
    asm volatile("s_waitcnt lgkmcnt(0)" ::: "memory");
    const int c = lane & 7;
#pragma unroll
    for (int j = 0; j < 4; ++j) { const int n = (lane >> 3) + 8 * j; const LAS float* s = scr + (8 * c) * 33 + n;
        v4u o; o.x = pkbf(s[0 * 33], s[1 * 33]); o.y = pkbf(s[2 * 33], s[3 * 33]); o.z = pkbf(s[4 * 33], s[5 * 33]); o.w = pkbf(s[6 * 33], s[7 * 33]);
        *(v4u*)(WT + (size_t)(drow0 + n) * K + k0 + 8 * c) = o; }
    asm volatile("s_waitcnt lgkmcnt(0)" ::: "memory");
}
template <int MODE> __device__ __forceinline__ void conv_mat(const float* W, const float* nw, int K, int N, bf16* WT, LAS float* scr, int gw, int NGW, int lane) {
    const int nblk = N / 32, nitems = (K / 64) * nblk;
    for (int it = gw; it < nitems; it += NGW) { const int kb = it / nblk, nb = it % nblk, n0 = 32 * nb; int d = n0;
        if (MODE == 1) { d = (n0 < DFF) ? 256 * (n0 / 128) + (n0 % 128) : 256 * ((n0 - DFF) / 128) + 128 + ((n0 - DFF) % 128); }
        tr_item(W, nw, K, N, WT, 64 * kb, n0, d, scr, lane); }
}
__device__ __forceinline__ void prep_rows_bf16(const float* X, float* rs, bf16* Hout, int gw, int NGW, int lane) {
    const bool xcd_deal = (NGW == 2048);
    for (int it = 0, m = xcd_deal ? gw * 8 : gw; m < M && (!xcd_deal || it < 8); ++it, m += xcd_deal ? 1 : NGW) { const f32x4* xr = (const f32x4*)(X + (size_t)m * DM) + lane; f32x4 v[8]; float s = 0.f;
#pragma unroll
        for (int j = 0; j < 8; ++j) { v[j] = xr[64 * j]; s += (v[j].x * v[j].x + v[j].y * v[j].y) + (v[j].z * v[j].z + v[j].w * v[j].w); }
        const float rstd = 1.0f / sqrtf(wave_sum(s) * (1.f / DM) + EPS);
        if (lane == 0) rs[m] = rstd;
        v2u* o = (v2u*)(Hout + (size_t)m * DM) + lane;
#pragma unroll
        for (int j = 0; j < 8; ++j) o[64 * j] = (v2u){pkbf(v[j].x, v[j].y), pkbf(v[j].z, v[j].w)}; }
}
__device__ __forceinline__ void norm_rows_f32_inplace(float* X, const float* ss, const float* w, int gw, int NGW, int lane) {
    for (int m = gw; m < M; m += NGW) { f32x4* xr = (f32x4*)(X + (size_t)m * DM) + lane; f32x4 v[8];
#pragma unroll
        for (int j = 0; j < 8; ++j) v[j] = xr[64 * j];
        const float rstd = epi::row_scale<1>(ss, m);
#pragma unroll
        for (int j = 0; j < 8; ++j) { const f32x4 ww = ((const f32x4*)w)[64 * j + lane]; xr[64 * j] = v[j] * rstd * ww; } }
}
__device__ __forceinline__ void unpack16(const bf16* p, float (&v)[16]) { const v4u a = *(const v4u*)p, b = *(const v4u*)(p + 8);
    v[0] = bflo(a.x); v[1] = bfhi(a.x); v[2] = bflo(a.y); v[3] = bfhi(a.y); v[4] = bflo(a.z); v[5] = bfhi(a.z); v[6] = bflo(a.w); v[7] = bfhi(a.w);
    v[8] = bflo(b.x); v[9] = bfhi(b.x); v[10] = bflo(b.y); v[11] = bfhi(b.y); v[12] = bflo(b.z); v[13] = bfhi(b.z); v[14] = bflo(b.w); v[15] = bfhi(b.w); }
__device__ __forceinline__ void pack16(bf16* p, const float (&v)[16]) {
    *(v4u*)p = (v4u){pkbf(v[0], v[1]), pkbf(v[2], v[3]), pkbf(v[4], v[5]), pkbf(v[6], v[7])}; *(v4u*)(p + 8) = (v4u){pkbf(v[8], v[9]), pkbf(v[10], v[11]), pkbf(v[12], v[13]), pkbf(v[14], v[15])}; }
__device__ __forceinline__ void combine_rows(const bf16* O1, const bf16* O2, const bf16* OR_, const bf16* Gs, bf16* YA, bf16* YR, float lam, const float* subln, const float* gnorm, int gw, int NGW, int lane) {
    const bool xcd_deal = (NGW == 2048);
    float wa[16], wg[16];
#pragma unroll
    for (int i = 0; i < 16; ++i) { wa[i] = subln[16 * (lane & 7) + i] * 0.8f; wg[i] = gnorm[16 * (lane & 7) + i]; }
    for (int it = 0, m = xcd_deal ? gw * 8 : gw; m < M && (!xcd_deal || it < 8); ++it, m += xcd_deal ? 1 : NGW) { const size_t p = (size_t)m * 1024 + 16 * lane;
        float a[16], b2[16], r[16], g[16]; unpack16(O1 + p, a); unpack16(O2 + p, b2); unpack16(OR_ + p, r); unpack16(Gs + p, g);
        float sa = 0.f, sr = 0.f;
#pragma unroll
        for (int i = 0; i < 16; ++i) { a[i] = a[i] - lam * b2[i]; sa += a[i] * a[i]; sr += r[i] * r[i]; }
        sa += __shfl_xor(sa, 1); sa += __shfl_xor(sa, 2); sa += __shfl_xor(sa, 4); sr += __shfl_xor(sr, 1); sr += __shfl_xor(sr, 2); sr += __shfl_xor(sr, 4);
        const float ra = 1.0f / sqrtf(sa * (1.f / 128.f) + EPS), rr = 1.0f / sqrtf(sr * (1.f / 128.f) + EPS);
#pragma unroll
        for (int i = 0; i < 16; ++i) { a[i] = a[i] * ra * wa[i]; r[i] = r[i] * rr * wg[i] * g[i]; }
        pack16(YA + p, a); pack16(YR + p, r); }
}

#define XB_TMO      128
#define XB_XCNT(j)  (256  + 64 * (j))
#define XB_XSUB(j)  (1280 + 64 * (j))
#define XB_XGEN(j)  (2304 + 64 * (j))
#define XB_TOP      3328
#define XB_TOPGEN   3392
#define XCD_BAR_WORDS 3456
#define XB_SPIN_CAP (1u << 18)

__device__ __forceinline__ unsigned xb_ld(unsigned* p)              { return __hip_atomic_load(p, __ATOMIC_RELAXED, __HIP_MEMORY_SCOPE_AGENT); }
__device__ __forceinline__ unsigned xb_add(unsigned* p, unsigned v) { return __hip_atomic_fetch_add(p, v, __ATOMIC_RELAXED, __HIP_MEMORY_SCOPE_AGENT); }
__device__ __forceinline__ unsigned xb_xcc_id() { return (unsigned)__builtin_amdgcn_s_getreg((3 << 11) | 20) & 0xFu; }
#define XB_SPIN(cond, bar) do { unsigned _sp = 0; while (cond) { __builtin_amdgcn_s_sleep(1); \
    if ((++_sp & 255u) == 0u) { if (xb_ld(&(bar)[XB_TMO])) break; if (_sp > XB_SPIN_CAP) { atomicAdd(&(bar)[XB_TMO], 1u); break; } } } } while (0)

struct XcdBarrier {
    unsigned* bar; unsigned x;
    volatile LAS unsigned* st;
};

__device__ __forceinline__ XcdBarrier xcd_barrier_post(unsigned* bar, volatile LAS unsigned* st) {
    XcdBarrier b; b.bar = bar; b.x = xb_xcc_id(); b.st = st;
    if (threadIdx.x == 0) (void)xb_add(&bar[XB_XCNT(b.x)], 1u);
    return b;
}
__device__ __forceinline__ void xcd_barrier_complete(unsigned* bar, unsigned x, unsigned& nloc, unsigned& nx) {
    const unsigned G = gridDim.x * gridDim.y * gridDim.z;
    unsigned sum, cnt, mine, sp = 0u;
    for (;;) {
        sum = 0u; cnt = 0u; mine = 0u;
#pragma unroll
        for (unsigned j = 0; j < 16; ++j) { const unsigned c = xb_ld(&bar[XB_XCNT(j)]); sum += c; cnt += (c > 0u) ? 1u : 0u; mine = (j == x) ? c : mine; }
        if (sum == G) break;
        __builtin_amdgcn_s_sleep(1);
        if ((++sp & 255u) == 0u) { if (xb_ld(&bar[XB_TMO])) break; if (sp > XB_SPIN_CAP) { atomicAdd(&bar[XB_TMO], 1u); break; } }
    }
    nloc = mine > 0u ? mine : 1u; nx = cnt > 0u ? cnt : 1u;
}

__device__ __forceinline__ void xcd_barrier(const XcdBarrier& b) {
    asm volatile("s_waitcnt vmcnt(0)" ::: "memory");
    __syncthreads();
    if (threadIdx.x == 0) {
        unsigned* bar = b.bar;
        __builtin_amdgcn_s_waitcnt(0);
        unsigned nloc = b.st[0], nx = b.st[1];
        if (nloc == 0u) { xcd_barrier_complete(bar, b.x, nloc, nx); b.st[0] = nloc; b.st[1] = nx; }
        const unsigned old = xb_add(&bar[XB_XSUB(b.x)], 1u);
        const unsigned gen = old / nloc;
        if (old + 1u == (gen + 1u) * nloc) {
            __builtin_amdgcn_fence(__ATOMIC_RELEASE, "agent");
            asm volatile("s_waitcnt vmcnt(0)" ::: "memory");
            const unsigned og = xb_add(&bar[XB_TOP], 1u);
            const unsigned tg = og / nx;
            if (og + 1u == (tg + 1u) * nx) xb_add(&bar[XB_TOPGEN], 1u);
            else XB_SPIN(xb_ld(&bar[XB_TOPGEN]) == tg, bar);
            __builtin_amdgcn_fence(__ATOMIC_ACQUIRE, "agent");
            xb_add(&bar[XB_XGEN(b.x)], 1u);
            asm volatile("s_waitcnt vmcnt(0)" ::: "memory");
        } else {
            XB_SPIN(xb_ld(&bar[XB_XGEN(b.x)]) == gen, bar);
            __builtin_amdgcn_fence(__ATOMIC_ACQUIRE, "agent");
            asm volatile("s_waitcnt vmcnt(0)" ::: "memory");
        }
    }
    __syncthreads();
}

struct Args { const float* in[20]; float* out; unsigned char* ws; };
enum { I_X = 0, I_F1N, I_F1I, I_F1O, I_MIXN, I_WIN, I_LQ1, I_LK1, I_LQ2, I_LK2, I_SUBLN, I_LBRAW, I_GNORM, I_WPA, I_WPR, I_WOUT, I_F2N, I_F2I, I_F2O, I_FINN };

__global__ void __launch_bounds__(512, 2) fwd_megakernel(Args a) {
    extern __shared__ __attribute__((aligned(16))) unsigned char lds_raw[];
    LAS unsigned char* lds = (LAS unsigned char*)lds_raw;
    cg::grid_group grid = cg::this_grid();
#define GRID_SYNC() do { asm volatile("s_waitcnt vmcnt(0) lgkmcnt(0)" ::: "memory"); __syncthreads(); grid.sync(); if (tid == 0) { __builtin_amdgcn_fence(__ATOMIC_ACQUIRE, "agent"); asm volatile("s_waitcnt vmcnt(0)" ::: "memory"); } __syncthreads(); } while (0)
    const int tid = threadIdx.x, lane = tid & 63, wave = __builtin_amdgcn_readfirstlane(tid >> 6);
    const int G = gridDim.x, bx = blockIdx.x, vcu = (G % 8 == 0) ? (bx % 8) * (G / 8) + bx / 8 : bx;
    const int gw = vcu * 8 + wave, NGW = G * 8;
    unsigned char* ws = a.ws;
    float* ropeC = (float*)(ws + WS_ROPE); float* ropeS = ropeC + SEQ * 8;
    bf16* WFI = (bf16*)(ws + WS_WFI); bf16* WFO = (bf16*)(ws + WS_WFO); bf16* WIN = (bf16*)(ws + WS_WIN);
    bf16* WPA = (bf16*)(ws + WS_WPA); bf16* WPR = (bf16*)(ws + WS_WPR); bf16* WWO = (bf16*)(ws + WS_WWO);
    bf16* H = (bf16*)(ws + WS_H); bf16* ACT = (bf16*)(ws + WS_BIG); bf16* P = (bf16*)(ws + WS_BIG);
    bf16* O1 = (bf16*)(ws + WS_Y); bf16* O2 = O1 + PBUF; bf16* T1 = (bf16*)(ws + WS_Y);
    bf16* YA = P + PB_QA * PBUF; bf16* YR = P + PB_KA * PBUF;
    float* out = a.out;
    float* RS0 = (float*)(ws + WS_SS); float* SS1 = RS0 + M; float* SS2 = SS1 + M; float* SS3 = SS2 + M;
    LAS float* scr = (LAS float*)(lds + wave * 16384);
    using pg8::Gemm; using pg8::StaticOrder; using pg8::gemm_phase;
    for (int u = tid; u < (LDS_BYTES - RING_BYTES) / 4; u += 512) ((LAS unsigned*)(lds + RING_BYTES))[u] = 0u;
    __syncthreads();
#define XSYNC() xcd_barrier(bar)

    for (int i = bx * 512 + tid; i < (int)(WS_ZERO_BYTES / 4); i += G * 512) ((unsigned*)(ws + WS_BAR))[i] = 0u;
    conv_mat<1>(a.in[I_F1I], a.in[I_F1N], DM, 2 * DFF, WFI, scr, gw, NGW, lane);
    conv_mat<0>(a.in[I_F1O], nullptr, DFF, DM, WFO, scr, gw, NGW, lane);
    conv_mat<0>(a.in[I_WIN], a.in[I_MIXN], DM, 11264, WIN, scr, gw, NGW, lane);
    conv_mat<0>(a.in[I_WPA], nullptr, 1024, DM, WPA, scr, gw, NGW, lane);
    conv_mat<0>(a.in[I_WPR], nullptr, 1024, DM, WPR, scr, gw, NGW, lane);
    conv_mat<0>(a.in[I_WOUT], nullptr, DM, DM, WWO, scr, gw, NGW, lane);
    for (int id = bx * 512 + tid; id < SEQ * 8; id += G * 512) { const int pos = id >> 3, i = id & 7;
        const float inv = powf(500000.0f, -(float)(2 * i) / 16.0f); const float ang = (float)pos * inv; ropeC[id] = cosf(ang); ropeS[id] = sinf(ang); }
    prep_rows_bf16(a.in[I_X], RS0, H, gw, NGW, lane);
    GRID_SYNC();
    XcdBarrier bar = xcd_barrier_post((unsigned*)(ws + WS_BAR), (volatile LAS unsigned*)(lds + RING_BYTES + 64));
    { Gemm g{H, WFI, M, 2 * DFF, DM}; StaticOrder S; S.init(M, 2 * DFF, G, bx); epi::EpiSwiglu<0> E{ACT, DFF, RS0};
      gemm_phase<epi::EpiSwiglu<0>, StaticOrder, true, true>(lds, g, S, E); }
    XSYNC();
    { Gemm g{ACT, WFO, M, DM, DFF}; StaticOrder S; S.init(M, DM, G, bx); epi::EpiResid<1, 1, true> E{a.in[I_X], out, ws};
      gemm_phase<epi::EpiResid<1, 1, true>, StaticOrder, true, true>(lds, g, S, E); }
    XSYNC();
    { Gemm g{H, WIN, M, 11264, DM}; StaticOrder S; S.init(M, 11264, G, bx); epi::EpiMix E{ws, a.in[I_LBRAW]};
      gemm_phase<epi::EpiMix, StaticOrder, true, true>(lds, g, S, E); }
    XSYNC();
    for (int u = vcu; u < 256; u += G) { const int pr = u & 3, bh = u >> 2, b = bh >> 3, h = bh & 7;
        for (int j = 0; j < 2; ++j)
            for (int half = 0; half < 2; ++half)
                for (int e = 0; e < 2; ++e) { const int qb = e == 0 ? 7 - pr : pr;
                    attn_body::attn_unit<8>(b, 2 * h + j, 2 * h + half, qb, (const attn_body::bf16*)(P + PB_QA * PBUF), (const attn_body::bf16*)(P + PB_KA * PBUF), (const attn_body::bf16*)(P + PB_VA * PBUF),
                                            (attn_body::bf16*)(j == 0 ? O1 : O2), (char*)lds_raw); }
        hg::hgrn_unit(lds, b, h, pr, P + PB_QR * PBUF, (const _Float16*)(P + PB_LF * PBUF), P + PB_IO * PBUF, (bf16*)(ws + WS_OR));
    }
    XSYNC();
    { const float d1 = wave_sum(a.in[I_LQ1][lane] * a.in[I_LK1][lane]), d2 = wave_sum(a.in[I_LQ2][lane] * a.in[I_LK2][lane]);
      const float lam = fexp(d1) - fexp(d2) + 0.2f;
      combine_rows(O1, O2, (const bf16*)(ws + WS_OR), P + PB_G * PBUF, YA, YR, lam, a.in[I_SUBLN], a.in[I_GNORM], gw, NGW, lane); }
    XSYNC();
    { StaticOrder S; S.init(M, DM, G, bx); const unsigned char* GA = ws + WS_WFI; const unsigned char* GB = GA + (size_t)M * DM;
      { Gemm g{YA, WPA, M, DM, 1024}; epi::EpiGate<0> E{T1, GA}; gemm_phase<epi::EpiGate<0>, StaticOrder, true, true>(lds, g, S, E); }
      { Gemm g{YR, WPR, M, DM, 1024}; epi::EpiGate<1> E{T1, GB}; gemm_phase<epi::EpiGate<1>, StaticOrder, true, true>(lds, g, S, E); } }
    XSYNC();
    conv_mat<1>(a.in[I_F2I], a.in[I_F2N], DM, 2 * DFF, WFI, scr, gw, NGW, lane);
    conv_mat<0>(a.in[I_F2O], nullptr, DFF, DM, WFO, scr, gw, NGW, lane);
    asm volatile("s_waitcnt vmcnt(0) lgkmcnt(0)" ::: "memory"); __syncthreads();
    { Gemm g{T1, WWO, M, DM, DM}; StaticOrder S; S.init(M, DM, G, bx); epi::EpiResid<1, 2, false> E{out, out, ws};
      gemm_phase<epi::EpiResid<1, 2, false>, StaticOrder, true, true>(lds, g, S, E); }
    XSYNC();
    { Gemm g{H, WFI, M, 2 * DFF, DM}; StaticOrder S; S.init(M, 2 * DFF, G, bx); epi::EpiSwiglu<1> E{ACT, DFF, SS2};
      gemm_phase<epi::EpiSwiglu<1>, StaticOrder, true, true>(lds, g, S, E); }
    XSYNC();
    if (G == 256) {
      Gemm g{ACT, WFO, M, DM, DFF}; epi::PanelOrder S{vcu}; epi::EpiFinal E{out, ws, a.in[I_FINN]};
      gemm_phase<epi::EpiFinal, epi::PanelOrder, true, true>(lds, g, S, E);
    } else {
      { Gemm g{ACT, WFO, M, DM, DFF}; StaticOrder S; S.init(M, DM, G, bx); epi::EpiResid<2, 3, true> E{out, out, ws};
        gemm_phase<epi::EpiResid<2, 3, true>, StaticOrder, true, true>(lds, g, S, E); }
      XSYNC();
      norm_rows_f32_inplace(out, SS3, a.in[I_FINN], gw, NGW, lane);
    }
}

extern "C" void kernel_launch(void* const* d_in, const int* in_sizes, int n_in, void* d_out, int out_size, void* d_ws, size_t ws_size, hipStream_t stream) {
    static int grid = 0;
    if (grid == 0) {
        if (n_in != 20 || out_size != M * DM || ws_size < WS_END) { fprintf(stderr, "kernel_launch: unexpected shapes (n_in %d out %d ws %zu)\n", n_in, out_size, ws_size); grid = -1; return; }
        int dev = 0, cus = 0, per_cu = 0;
        hipGetDevice(&dev); hipDeviceGetAttribute(&cus, hipDeviceAttributeMultiprocessorCount, dev);
        if (hipFuncSetAttribute((const void*)fwd_megakernel, hipFuncAttributeMaxDynamicSharedMemorySize, LDS_BYTES) != hipSuccess) { fprintf(stderr, "kernel_launch: hipFuncSetAttribute failed\n"); grid = -1; return; }
        if (hipOccupancyMaxActiveBlocksPerMultiprocessor(&per_cu, (const void*)fwd_megakernel, 512, LDS_BYTES) != hipSuccess || per_cu < 1) { fprintf(stderr, "kernel_launch: occupancy query says %d\n", per_cu); per_cu = 1; }
        (void)hipGetLastError();
        grid = cus * 1;
    }
    if (grid < 0) return;
    Args a{};
    for (int i = 0; i < 20; ++i) a.in[i] = (const float*)d_in[i];
    a.out = (float*)d_out; a.ws = (unsigned char*)d_ws;
    void* args[] = {&a};
    hipError_t e = hipLaunchCooperativeKernel((const void*)fwd_megakernel, dim3(grid), dim3(512), args, LDS_BYTES, stream);
    if (e != hipSuccess) fprintf(stderr, "cooperative launch failed: %s (grid %d)\n", hipGetErrorString(e), grid);
}
```

```cpp
#include <hip/hip_runtime.h>
#include <cstdio>
#include <cstdint>
namespace pg8 {
#define PG8_LAS __attribute__((address_space(3)))
typedef unsigned short bf16_t;
typedef short bf16x8 __attribute__((ext_vector_type(8)));
typedef float f32x4 __attribute__((ext_vector_type(4)));
typedef unsigned u32x4 __attribute__((ext_vector_type(4)));
constexpr int BM = 256, BK = 64, HALF = 128, HTB = HALF * BK * 2  , STAGE_BYTES = 8 * HTB, NXCD = 8, WGM = 8;

__host__ __device__ __forceinline__ int lds_byte(int r, int c) { const int st = (r >> 4) * 2 + (c >> 5), rr = r & 15, cc = c & 31, ob = rr * 64 + cc * 2; return st * 1024 + (ob ^ (((ob >> 9) & 1) << 5)); }
__host__ __device__ __forceinline__ void stage_rc(int b, int& R, int& C) { const int st = b / 1024, sb = b % 1024, swz = sb ^ (((sb >> 9) & 1) << 5); R = (st >> 1) * 16 + swz / 64; C = (st & 1) * 32 + (swz % 64) / 2; }
__host__ __device__ __forceinline__ int perm32(int rho) { const int n = rho >> 4, i = rho & 15; return 8 * (i >> 2) + 4 * n + (i & 3); }

struct Unit { int pm, pn; };
struct Gemm { const bf16_t* A; const bf16_t* Bt; int M, N, K; };

struct StaticOrder {
    int nM, nN, nwg, G, c;
    __host__ __device__ void init(int M, int N, int G_, int c_) { nM = M / BM; nN = N / BM; nwg = nM * nN; G = G_; c = c_; }
    __host__ __device__ bool next(int i, Unit& u) const {
        const long L = (long)i * G + c; if (L >= nwg) return false;
        int wgid = (int)L; { const int q = nwg / NXCD, r = nwg % NXCD, xcd = wgid % NXCD, off = wgid / NXCD; wgid = (xcd < r ? xcd * (q + 1) : r * (q + 1) + (xcd - r) * q) + off; }
        const int nig = WGM * nN, gid = wgid / nig, fm = gid * WGM, gsz = (nM - fm) < WGM ? (nM - fm) : WGM;
        u.pm = fm + ((wgid % nig) % gsz); u.pn = (wgid % nig) / gsz; return true;
    }
    __device__ __forceinline__ void a_ready(const Unit&) const {}
    __device__ __forceinline__ void done(const Unit&) const {}
};

__device__ __forceinline__ unsigned cvt_pk_bf16(float lo, float hi) { unsigned r; asm volatile("v_cvt_pk_bf16_f32 %0, %1, %2" : "=v"(r) : "v"(lo), "v"(hi)); return r; }
typedef float f32x2 __attribute__((ext_vector_type(2)));
template <class Epi, class Sched, bool ALIGN_EPI = false, bool SP2 = false>
__device__ __forceinline__ void gemm_phase(PG8_LAS unsigned char* lds, const Gemm g, const Sched& S, const Epi& E) {
    int tid_ = threadIdx.x; asm volatile("" : "+v"(tid_));
    const int tid = tid_, wid = __builtin_amdgcn_readfirstlane(tid >> 6), lane = tid & 63, wr = wid >> 2, wc = wid & 3, fr = lane & 15, fq = lane >> 4;
    const int K = g.K, nt = K / BK;
    unsigned voffA[2], voffB[2];
#pragma unroll
    for (int i = 0; i < 2; ++i) { int R, C; stage_rc(tid * 16 + i * 8192, R, C); const int Rb = Epi::PERM ? ((R & ~31) + perm32(R & 31)) : R;
        voffA[i] = (unsigned)(R * K + C) * 2u; voffB[i] = (unsigned)(Rb * K + C) * 2u; }
    const size_t kstep = (size_t)(BK * 2);
    const size_t hstep = (size_t)HALF * K * 2;
    const size_t tstep = 2 * hstep;
    const unsigned ldsw = (unsigned)wid * 1024u;
    const int aoff = lds_byte(wr * 64 + fr, fq * 8), boff = lds_byte(wc * 32 + fr, fq * 8);
#define PG8_SA(b, h) (((b) * 2 + (h)) * HTB)
#define PG8_SB(b, h) ((4 + (b) * 2 + (h)) * HTB)
#define PG8_STAGE(bufoff, gbase, voff) do { _Pragma("unroll") for (int _i = 0; _i < 2; ++_i) \
        __builtin_amdgcn_global_load_lds((const unsigned*)((const char*)(gbase) + (voff)[_i]), (PG8_LAS unsigned*)(lds + (bufoff) + ldsw + _i * 8192), 16, 0, 0); } while (0)
#define PG8_LDA(dst, b, h) do { _Pragma("unroll") for (int m = 0; m < 4; ++m) _Pragma("unroll") for (int k = 0; k < 2; ++k) dst[m][k] = *(const PG8_LAS bf16x8*)(lds + PG8_SA(b, h) + aoff + m * 2048 + k * 1024); } while (0)
#define PG8_LDB(dst, b, h) do { _Pragma("unroll") for (int n = 0; n < 2; ++n) _Pragma("unroll") for (int k = 0; k < 2; ++k) dst[n][k] = *(const PG8_LAS bf16x8*)(lds + PG8_SB(b, h) + boff + n * 2048 + k * 1024); } while (0)
#define PG8_MMA(ai, bj, At, Bt) do { __builtin_amdgcn_s_setprio(1); _Pragma("unroll") for (int m = 0; m < 4; ++m) _Pragma("unroll") for (int n = 0; n < 2; ++n) _Pragma("unroll") for (int k = 0; k < 2; ++k) \
        acc[ai][bj][m][n] = __builtin_amdgcn_mfma_f32_16x16x32_bf16(Bt[n][k], At[m][k], acc[ai][bj][m][n], 0, 0, 0); __builtin_amdgcn_s_setprio(0); } while (0)
#define PG8_WAIT_V(n) asm volatile("s_waitcnt vmcnt(" #n ")" ::: "memory")
#define PG8_WAIT_L(n) asm volatile("s_waitcnt lgkmcnt(" #n ")" ::: "memory")
#define PG8_BAR __builtin_amdgcn_s_barrier()
#define PG8_SCHED __builtin_amdgcn_sched_barrier(0)
    Unit cur, nxt; int ui = 0;
    if (!S.next(0, cur)) return;
    f32x4 acc[2][2][4][2];
#pragma unroll
    for (int a = 0; a < 2; ++a)
#pragma unroll
        for (int b = 0; b < 2; ++b)
#pragma unroll
            for (int m = 0; m < 4; ++m)
#pragma unroll
                for (int n = 0; n < 2; ++n) acc[a][b][m][n] = (f32x4){0.f, 0.f, 0.f, 0.f};
    bf16x8 At[4][2], B0[2][2], B1[2][2];
    const char* cA = (const char*)g.A + (size_t)cur.pm * tstep; const char* cB = (const char*)g.Bt + (size_t)cur.pn * tstep;
    S.a_ready(cur);
    if constexpr (SP2) {
        PG8_STAGE(PG8_SB(0, 0), cB, voffB); PG8_STAGE(PG8_SB(0, 1), cB + hstep, voffB); PG8_STAGE(PG8_SA(0, 0), cA, voffA); PG8_STAGE(PG8_SA(0, 1), cA + hstep, voffA);
        if (wr == 1) PG8_BAR;
        PG8_WAIT_V(2); PG8_BAR;
        PG8_STAGE(PG8_SB(1, 0), cB + kstep, voffB); PG8_STAGE(PG8_SA(1, 0), cA + kstep, voffA); PG8_STAGE(PG8_SB(1, 1), cB + hstep + kstep, voffB);
        PG8_WAIT_V(6); PG8_BAR;
    } else {
        PG8_STAGE(PG8_SB(0, 0), cB, voffB); PG8_STAGE(PG8_SA(0, 0), cA, voffA); PG8_STAGE(PG8_SB(0, 1), cB + hstep, voffB); PG8_STAGE(PG8_SA(0, 1), cA + hstep, voffA);
        if (wr == 1) PG8_BAR;
        PG8_WAIT_V(4); PG8_BAR;
        PG8_STAGE(PG8_SB(1, 0), cB + kstep, voffB); PG8_STAGE(PG8_SA(1, 0), cA + kstep, voffA); PG8_STAGE(PG8_SB(1, 1), cB + hstep + kstep, voffB);
        PG8_WAIT_V(6); PG8_BAR;
    }
    for (;;) {
        const bool has_next = S.next(ui + 1, nxt);
        const char* nA = has_next ? (const char*)g.A + (size_t)nxt.pm * tstep : cA; const char* nB = has_next ? (const char*)g.Bt + (size_t)nxt.pn * tstep : cB;
        for (int t = 0; t < nt; t += 2) {
            const bool last = (t == nt - 2);
            const char* a1 = cA + (size_t)(t + 1) * kstep;
            const char* a2 = last ? nA : cA + (size_t)(t + 2) * kstep; const char* b2 = last ? nB : cB + (size_t)(t + 2) * kstep;
            const char* a3 = a2 + kstep; const char* b3 = b2 + kstep;
            if (last && has_next) S.a_ready(nxt);
            if constexpr (SP2) {
            PG8_LDB(B0, 0, 0); PG8_LDB(B1, 0, 1); PG8_SCHED; PG8_LDA(At, 0, 0); PG8_STAGE(PG8_SA(1, 1), a1 + hstep, voffA);
            PG8_WAIT_V(8); PG8_WAIT_L(0); PG8_BAR; PG8_MMA(0, 0, At, B0); PG8_MMA(0, 1, At, B1); PG8_BAR; PG8_SCHED;
            PG8_LDA(At, 0, 1); PG8_STAGE(PG8_SB(0, 0), b2, voffB); PG8_STAGE(PG8_SB(0, 1), b2 + hstep, voffB); PG8_STAGE(PG8_SA(0, 0), a2, voffA);
            PG8_WAIT_V(8); PG8_WAIT_L(0); PG8_BAR; PG8_MMA(1, 0, At, B0); PG8_MMA(1, 1, At, B1); PG8_BAR; PG8_SCHED;
            PG8_LDB(B0, 1, 0); PG8_LDB(B1, 1, 1); PG8_SCHED; PG8_LDA(At, 1, 0); PG8_STAGE(PG8_SA(0, 1), a2 + hstep, voffA);
            PG8_WAIT_V(8); PG8_WAIT_L(0); PG8_BAR; PG8_MMA(0, 0, At, B0); PG8_MMA(0, 1, At, B1); PG8_BAR; PG8_SCHED;
            PG8_LDA(At, 1, 1); PG8_STAGE(PG8_SB(1, 0), b3, voffB); PG8_STAGE(PG8_SB(1, 1), b3 + hstep, voffB); PG8_STAGE(PG8_SA(1, 0), a3, voffA);
            PG8_WAIT_V(8); PG8_WAIT_L(0); PG8_BAR; PG8_MMA(1, 0, At, B0); PG8_MMA(1, 1, At, B1); PG8_BAR; PG8_SCHED;
            } else {
            PG8_LDB(B0, 0, 0); PG8_SCHED; PG8_LDA(At, 0, 0); PG8_STAGE(PG8_SA(1, 1), a1 + hstep, voffA);
            PG8_WAIT_L(8); PG8_BAR; PG8_WAIT_L(0); PG8_MMA(0, 0, At, B0); PG8_BAR; PG8_SCHED;
            PG8_LDB(B1, 0, 1); PG8_STAGE(PG8_SB(0, 0), b2, voffB);
            PG8_BAR; PG8_WAIT_L(0); PG8_MMA(0, 1, At, B1); PG8_BAR;
            PG8_LDA(At, 0, 1); PG8_STAGE(PG8_SA(0, 0), a2, voffA);
            PG8_BAR; PG8_WAIT_L(0); PG8_MMA(1, 0, At, B0); PG8_BAR; PG8_SCHED;
            PG8_STAGE(PG8_SB(0, 1), b2 + hstep, voffB);
            PG8_WAIT_V(6); PG8_BAR; PG8_MMA(1, 1, At, B1); PG8_BAR;
            PG8_LDB(B0, 1, 0); PG8_SCHED; PG8_LDA(At, 1, 0); PG8_STAGE(PG8_SA(0, 1), a2 + hstep, voffA);
            PG8_WAIT_L(8); PG8_BAR; PG8_WAIT_L(0); PG8_MMA(0, 0, At, B0); PG8_BAR; PG8_SCHED;
            PG8_LDB(B1, 1, 1); PG8_STAGE(PG8_SB(1, 0), b3, voffB);
            PG8_BAR; PG8_WAIT_L(0); PG8_MMA(0, 1, At, B1); PG8_BAR;
            PG8_LDA(At, 1, 1); PG8_STAGE(PG8_SA(1, 0), a3, voffA);
            PG8_BAR; PG8_WAIT_L(0); PG8_MMA(1, 0, At, B0); PG8_BAR; PG8_SCHED;
            PG8_STAGE(PG8_SB(1, 1), b3 + hstep, voffB);
            PG8_WAIT_V(6); PG8_BAR; PG8_MMA(1, 1, At, B1); PG8_BAR;
            }
        }
        if constexpr (ALIGN_EPI) { if (wr == 0) PG8_BAR; }
        if constexpr (!Epi::AFTER_DRAIN) { E(acc, cur, wr, wc, fr, fq); S.done(cur); }
        if (!has_next) break;
#pragma unroll
        for (int a = 0; a < 2; ++a)
#pragma unroll
            for (int b = 0; b < 2; ++b)
#pragma unroll
                for (int m = 0; m < 4; ++m)
#pragma unroll
                    for (int n = 0; n < 2; ++n) acc[a][b][m][n] = (f32x4){0.f, 0.f, 0.f, 0.f};
        cur = nxt; cA = nA; cB = nB; ++ui;
        if constexpr (ALIGN_EPI) { if (wr == 1) PG8_BAR; }
    }
    PG8_WAIT_V(0);
    if constexpr (!ALIGN_EPI) { if (wr == 0) PG8_BAR; }
    PG8_BAR;
    if constexpr (Epi::AFTER_DRAIN) { E.fused(acc, cur, wr, wc, fr, fq, lds, wid, lane); S.done(cur); }
#undef PG8_SA
#undef PG8_SB
#undef PG8_STAGE
#undef PG8_LDA
#undef PG8_LDB
#undef PG8_MMA
#undef PG8_WAIT_V
#undef PG8_WAIT_L
#undef PG8_BAR
#undef PG8_SCHED
}
}

#ifndef PG8_SP2
#define PG8_SP2 true
#endif
#ifndef PG8_ALIGN
#define PG8_ALIGN true
#endif
#include <hip/hip_bf16.h>
#include <cmath>
namespace attn_body {
using bf16=__hip_bfloat16;
using bf16x8=__attribute__((ext_vector_type(8)))short;
using s16x4=__attribute__((ext_vector_type(4)))short;
using f32x16=__attribute__((ext_vector_type(16)))float;
using u32x4=__attribute__((ext_vector_type(4)))unsigned;
constexpr int BATCH=8,NHEAD=16,SEQ=2048,D=64,DM=NHEAD*D;
constexpr int NW=8,QBLK=32,QB=QBLK*NW,KVBLK=64,NQB=SEQ/QB;
constexpr int ATTN_PITCH=DM, ATTN_UNIT_ROWS=QB;
__device__ __forceinline__ int crow(int r,int hi){return (r&3)+8*(r>>2)+4*hi;}
#define SBAR() __builtin_amdgcn_sched_barrier(0)
__device__ __forceinline__ void cmask(f32x16&p0,f32x16&p1,int jb,int qrel,int hi){
  const float NEG=-INFINITY; int kb=64*jb+4*hi;
  #pragma unroll
  for(int r=0;r<16;++r){int kv=kb+(r&3)+8*(r>>2); if(kv>qrel)p0[r]=NEG; if(kv+32>qrel)p1[r]=NEG;}
}

constexpr int NSLOT=3, SLOTB=8192;
constexpr int LDS_K=0, LDS_V=NSLOT*SLOTB, LDS_WS=2*NSLOT*SLOTB, LDS_OST=LDS_WS+NW*64*4, LDS_BYTES=LDS_OST+NW*4096;
constexpr float C2=0.125f*1.4426950408889634f;
__device__ __forceinline__ void glds16(const void*gsrc,unsigned lds_dst){unsigned keep;
  asm volatile("s_mov_b32 %0, m0\n\ts_mov_b32 m0, %2\n\ts_nop 0\n\tglobal_load_lds_dwordx4 %1, off\n\ts_mov_b32 m0, %0":"=&s"(keep):"v"(gsrc),"s"(lds_dst):"memory");}
__device__ __forceinline__ float max3f(float a,float b,float c){float r;asm("v_max3_f32 %0, %1, %2, %3":"=v"(r):"v"(a),"v"(b),"v"(c));return r;}
__device__ __forceinline__ float max2f(float a,float b){float r;asm("v_max_f32_e32 %0, %1, %2":"=v"(r):"v"(a),"v"(b));return r;}
__device__ __forceinline__ float fadd_s(float a,float b){float r;asm("v_add_f32_e32 %0, %1, %2":"=v"(r):"v"(a),"v"(b));return r;}
__device__ __forceinline__ float fsub_s(float a,float b){float r;asm("v_sub_f32_e32 %0, %1, %2":"=v"(r):"v"(a),"v"(b));return r;}
typedef float f32x2_t __attribute__((ext_vector_type(2))); typedef __bf16 bf16x2_t __attribute__((ext_vector_type(2)));
__device__ __forceinline__ unsigned cvtpk_s(float lo,float hi){f32x2_t v={lo,hi};bf16x2_t b=__builtin_convertvector(v,bf16x2_t);return __builtin_bit_cast(unsigned,b);}
#define WAIT_BAR(N) asm volatile("s_waitcnt vmcnt(" #N ") lgkmcnt(0)\n\ts_barrier":::"memory")

__device__ __forceinline__ void qkt(f32x16&p0,f32x16&p1,const char*Kslot,const bf16x8*qr,const f32x16&negm,int r32,int hi){
  const char*kb=Kslot+hi*1024+r32*16;
  #pragma unroll
  for(int d0=0;d0<4;++d0){
    const bf16x8 b0=*reinterpret_cast<const bf16x8*>(kb+d0*2048);
    const bf16x8 b1=*reinterpret_cast<const bf16x8*>(kb+d0*2048+512);
    if(d0==0){p0=__builtin_amdgcn_mfma_f32_32x32x16_bf16(b0,qr[0],negm,0,0,0);p1=__builtin_amdgcn_mfma_f32_32x32x16_bf16(b1,qr[0],negm,0,0,0);}
    else{p0=__builtin_amdgcn_mfma_f32_32x32x16_bf16(b0,qr[d0],p0,0,0,0);p1=__builtin_amdgcn_mfma_f32_32x32x16_bf16(b1,qr[d0],p1,0,0,0);}}
}
typedef __attribute__((address_space(3))) const char* lds_cptr;
typedef short v4i16_t __attribute__((ext_vector_type(4)));
__device__ __forceinline__ void kload8(bf16x8*kf,lds_cptr kp){
  kf[0]=*(const __attribute__((address_space(3))) bf16x8*)(kp);      kf[1]=*(const __attribute__((address_space(3))) bf16x8*)(kp+512);
  kf[2]=*(const __attribute__((address_space(3))) bf16x8*)(kp+2048); kf[3]=*(const __attribute__((address_space(3))) bf16x8*)(kp+2560);
  kf[4]=*(const __attribute__((address_space(3))) bf16x8*)(kp+4096); kf[5]=*(const __attribute__((address_space(3))) bf16x8*)(kp+4608);
  kf[6]=*(const __attribute__((address_space(3))) bf16x8*)(kp+6144); kf[7]=*(const __attribute__((address_space(3))) bf16x8*)(kp+6656);
}
__device__ __forceinline__ void kload2(bf16x8*kf,lds_cptr kp,int j){ kf[2*j]=*(const __attribute__((address_space(3))) bf16x8*)(kp+j*2048); kf[2*j+1]=*(const __attribute__((address_space(3))) bf16x8*)(kp+j*2048+512); }
__device__ __forceinline__ s16x4 vtr(lds_cptr p){ return __builtin_bit_cast(s16x4,__builtin_amdgcn_ds_read_tr16_b64_v4i16((__attribute__((address_space(3))) v4i16_t*)p)); }
__device__ __forceinline__ float rowmax(const f32x16&p0,const f32x16&p1){
  float a=max3f(p0[0],p0[1],p1[0]),b=max3f(p0[2],p0[3],p1[1]);a=max3f(a,p1[2],p1[3]);
  #pragma unroll
  for(int r=4;r<16;r+=4){a=max3f(a,p0[r],p0[r+1]);b=max3f(b,p0[r+2],p0[r+3]);a=max3f(a,p1[r],p1[r+1]);b=max3f(b,p1[r+2],p1[r+3]);}
  const float m=max2f(a,b);
  auto rr=__builtin_amdgcn_permlane32_swap(__float_as_uint(m),__float_as_uint(m),false,false);
  return max2f(__uint_as_float(rr[0]),__uint_as_float(rr[1]));
}
__device__ __forceinline__ void pv(f32x16*o,int vb,bf16x8 pa0,bf16x8 pa1,bf16x8 pa2,bf16x8 pa3){
  #pragma unroll
  for(int d0=0;d0<2;++d0){s16x4 lo[4],hi[4];
    #pragma unroll
    for(int ks=0;ks<4;++ks){
      asm volatile("ds_read_b64_tr_b16 %0,%1 offset:%c2":"=&v"(lo[ks]):"v"(vb),"i"(d0*4096+ks*1024):"memory");
      asm volatile("ds_read_b64_tr_b16 %0,%1 offset:%c2":"=&v"(hi[ks]):"v"(vb),"i"(d0*4096+ks*1024+512):"memory");}
    asm volatile("s_waitcnt lgkmcnt(0)":::"memory");SBAR();
    #define PK(k) (bf16x8){lo[k][0],lo[k][1],lo[k][2],lo[k][3],hi[k][0],hi[k][1],hi[k][2],hi[k][3]}
    o[d0]=__builtin_amdgcn_mfma_f32_32x32x16_bf16(pa0,PK(0),o[d0],0,0,0);
    o[d0]=__builtin_amdgcn_mfma_f32_32x32x16_bf16(pa1,PK(1),o[d0],0,0,0);
    o[d0]=__builtin_amdgcn_mfma_f32_32x32x16_bf16(pa2,PK(2),o[d0],0,0,0);
    o[d0]=__builtin_amdgcn_mfma_f32_32x32x16_bf16(pa3,PK(3),o[d0],0,0,0);
    #undef PK
  }
}

#ifndef ATTN_STORE16
#define ATTN_STORE16(p,v) (*(u32x4*)(p)=(v))
#endif
template<int THRL> __device__ __forceinline__ void attn_unit(int b,int h,int hv,int qb,const bf16*Q,const bf16*__restrict__ K,const bf16*__restrict__ V,bf16*O,char*shm){
  int tid_=threadIdx.x; asm volatile("":"+v"(tid_)); const int tid=tid_,lane=tid&63,r32=lane&31,hi=lane>>5; const int wid=__builtin_amdgcn_readfirstlane(tid>>6);
  const long rowbase=(long)b*SEQ; const int q0=qb*QB;
  const bf16*Qw=Q+(rowbase+q0+wid*QBLK)*DM+h*D;
  const bf16*Kh=K+rowbase*DM+h*D,*Vh=V+rowbase*DM+hv*D;
  const unsigned lds0=(unsigned)(uintptr_t)shm;
  float*wsf=(float*)(shm+LDS_WS)+wid*64;
  const bf16*ksrc=Kh+(long)lane*DM+wid*8;
  const bf16*vsrc=Vh+(long)(16*(wid&3)+(lane>>2))*DM+(wid>>2)*32+(lane&3)*8;
  const unsigned kdst=lds0+LDS_K+wid*1024, vdst=lds0+LDS_V+wid*1024;
  #define DMA_K(t,slot) glds16(ksrc+(long)(t)*KVBLK*DM,(unsigned)__builtin_amdgcn_readfirstlane(kdst+(slot)))
  #define DMA_V(t,slot) glds16(vsrc+(long)(t)*KVBLK*DM,(unsigned)__builtin_amdgcn_readfirstlane(vdst+(slot)))
  const int vb0=(int)(lds0+LDS_V)+((lane>>4)&1)*32+(lane&3)*8+(4*hi+((lane&15)>>2))*64;
  const char*Kbase=shm+LDS_K; bf16x8 kf[8];
  const lds_cptr shm3=(lds_cptr)shm; const lds_cptr kp0=shm3+LDS_K+hi*1024+r32*16; const lds_cptr vp0=shm3+LDS_V+((lane>>4)&1)*32+(lane&3)*8+(4*hi+((lane&15)>>2))*64;
  const int NT=(q0+QB)/KVBLK;
  DMA_K(0,0);DMA_V(0,0);DMA_K(1,SLOTB);
  bf16x8 qr[4];
  #pragma unroll
  for(int d0=0;d0<4;++d0)qr[d0]=*reinterpret_cast<const bf16x8*>(&Qw[(long)r32*DM+d0*16+hi*8]);
  float mhat=0.f,l_reg=0.f;f32x16 o[2];o[0]=f32x16{};o[1]=f32x16{};f32x16 negm=f32x16{};asm volatile("":"+v"(negm));
  const int qrel=wid*QBLK+r32;
  #define CMASK(P0,P1,t) do{int jb_=(t)-(NT-4); if(jb_>=0)cmask(P0,P1,jb_,qrel,hi);}while(0)
  bool resc=false;
  #define START(P0,P1) do{ const float rm=rowmax(P0,P1); resc=false; \
    { const float dl=rm; mhat=fadd_s(mhat,dl); \
      _Pragma("unroll") for(int r=0;r<16;++r){P0[r]=fsub_s(P0[r],dl);P1[r]=fsub_s(P1[r],dl);} \
      _Pragma("unroll") for(int r=0;r<16;++r)negm[r]=-mhat; asm volatile("":"+v"(negm)); } \
    _Pragma("unroll") for(int r=0;r<16;++r)P0[r]=__builtin_amdgcn_exp2f(P0[r]); }while(0)
  #define RESC() do{ if(resc){ asm volatile("s_waitcnt lgkmcnt(0)":::"memory"); \
      _Pragma("unroll") for(int d_=0;d_<2;++d_) _Pragma("unroll") for(int r=0;r<16;++r)o[d_][r]*=wsf[crow(r,hi)]; } }while(0)
  f32x16 pA0,pA1,pB0,pB1;
  int sl_prev=0,sl_cur=0,sl_next=SLOTB;
  #define ROT() do{sl_prev=sl_cur;sl_cur=sl_next;sl_next=(sl_next==(NSLOT-1)*SLOTB)?0:sl_next+SLOTB;}while(0)
  DMA_K(2,2*SLOTB);
  WAIT_BAR(3);
  qkt(pA0,pA1,Kbase,qr,negm,r32,hi);asm volatile("s_nop 15\n\ts_nop 7":"+v"(pA0),"+v"(pA1));CMASK(pA0,pA1,0);
  START(pA0,pA1);
  _Pragma("unroll") for(int r=0;r<16;++r)pA1[r]=__builtin_amdgcn_exp2f(pA1[r]);
  WAIT_BAR(0);
  DMA_K(3,0);DMA_V(1,SLOTB);
  ROT();
  kload8(kf,kp0+sl_cur);
  WAIT_BAR(2);
  s16x4 vlo[8],vhi[8]; u32x4 pw0,pw1,pw2,pw3;
  #define PKW(P,B) cvtpk_s(P[B],P[B+1])
  #define PAF(k) __builtin_bit_cast(bf16x8,pw##k)
  #define VFR(i) (bf16x8){vlo[i][0],vlo[i][1],vlo[i][2],vlo[i][3],vhi[i][0],vhi[i][1],vhi[i][2],vhi[i][3]}
  #define PIN(x) asm volatile("":"+v"(x))
  #define MX3(a,b,c) __builtin_fmaxf(__builtin_fmaxf((a),(b)),(c))
  #define GAPA(MF,A0,A1,A2,A3,W0,W1,PW) do{ MF; sacc+=A0; sacc+=A1; sacc+=A2; sacc+=A3; PIN(sacc); W0; W1; PIN(PW); SBAR(); }while(0)
  #define EX(v) __builtin_amdgcn_exp2f(v)
  #define GAPB(MF,X,B) do{ MF; X[B]=EX(X[B]); X[B+1]=EX(X[B+1]); X[B+2]=EX(X[B+2]); X[B+3]=EX(X[B+3]); PIN(X); SBAR(); }while(0)
  #define VRD(i) do{ vlo[i]=vtr(vp_+(((i)>>2)*4096+((i)&3)*1024)); vhi[i]=vtr(vp_+(((i)>>2)*4096+((i)&3)*1024+512)); }while(0)
  #define KRD(G,j) do{ if(G){ kload2(kf,kp0+sl_next,j); SBAR(); } }while(0)
  #define STEP(C0,C1,P0,P1,t,GK,GV,GL) do{ SBAR(); \
    const lds_cptr vp_=vp0+sl_prev; \
    VRD(0); SBAR(); float sacc=(P0[0]+P0[1]); \
    GAPA(C0=__builtin_amdgcn_mfma_f32_32x32x16_bf16(kf[0],qr[0],negm,0,0,0), P0[2],P0[3],P0[4],P0[5],     pw0[0]=PKW(P0,0), pw0[1]=PKW(P0,2), pw0); \
    VRD(4); SBAR(); GAPA(C1=__builtin_amdgcn_mfma_f32_32x32x16_bf16(kf[1],qr[0],negm,0,0,0), P0[6],P0[7],P0[8],P0[9],     pw0[2]=PKW(P0,4), pw0[3]=PKW(P0,6), pw0); \
    VRD(1); SBAR(); GAPA(C0=__builtin_amdgcn_mfma_f32_32x32x16_bf16(kf[2],qr[1],C0,0,0,0),   P0[10],P0[11],P0[12],P0[13], pw1[0]=PKW(P0,8), pw1[1]=PKW(P0,10), pw1); \
    VRD(5); SBAR(); GAPA(C1=__builtin_amdgcn_mfma_f32_32x32x16_bf16(kf[3],qr[1],C1,0,0,0),   P0[14],P0[15],P1[0],P1[1],   pw1[2]=PKW(P0,12),pw1[3]=PKW(P0,14), pw1); \
    VRD(2); SBAR(); GAPA(C0=__builtin_amdgcn_mfma_f32_32x32x16_bf16(kf[4],qr[2],C0,0,0,0),   P1[2],P1[3],P1[4],P1[5],     pw2[0]=PKW(P1,0), pw2[1]=PKW(P1,2), pw2); \
    VRD(6); SBAR(); GAPA(C1=__builtin_amdgcn_mfma_f32_32x32x16_bf16(kf[5],qr[2],C1,0,0,0),   P1[6],P1[7],P1[8],P1[9],     pw2[2]=PKW(P1,4), pw2[3]=PKW(P1,6), pw2); \
    VRD(3); SBAR(); GAPA(C0=__builtin_amdgcn_mfma_f32_32x32x16_bf16(kf[6],qr[3],C0,0,0,0),   P1[10],P1[11],P1[12],P1[13], pw3[0]=PKW(P1,8), pw3[1]=PKW(P1,10), pw3); \
    VRD(7); SBAR(); GAPA(C1=__builtin_amdgcn_mfma_f32_32x32x16_bf16(kf[7],qr[3],C1,0,0,0),   P1[14],P1[15],0.f,0.f,       pw3[2]=PKW(P1,12),pw3[3]=PKW(P1,14), pw3); \
    l_reg+=sacc; \
    if(GK){DMA_K((t)+3,sl_cur);} if(GV){DMA_V((t)+1,sl_next);} \
    CMASK(C0,C1,t); \
    { float a=MX3(C0[0],C0[1],C1[0]),b=MX3(C0[2],C0[3],C1[1]); a=MX3(a,C1[2],C1[3]); \
      _Pragma("unroll") for(int r=4;r<16;r+=4){a=MX3(a,C0[r],C0[r+1]);b=MX3(b,C0[r+2],C0[r+3]);a=MX3(a,C1[r],C1[r+1]);b=MX3(b,C1[r+2],C1[r+3]);} \
      float rm=__builtin_fmaxf(a,b); { auto rr=__builtin_amdgcn_permlane32_swap(__float_as_uint(rm),__float_as_uint(rm),false,false); rm=__builtin_fmaxf(__uint_as_float(rr[0]),__uint_as_float(rr[1])); } \
      resc=false; \
      if(__builtin_expect(__any(rm>(float)THRL),0)){ const float dl=__builtin_fmaxf(rm,0.f); mhat+=dl; \
        _Pragma("unroll") for(int r=0;r<16;++r){C0[r]-=dl;C1[r]-=dl;} \
        _Pragma("unroll") for(int r=0;r<16;++r)negm[r]=-mhat; asm volatile("":"+v"(negm)); \
        const float f=__builtin_amdgcn_exp2f(-dl); l_reg*=f; if(hi==0)wsf[r32]=f; resc=true; } } \
    SBAR(); \
    GAPB(o[0]=__builtin_amdgcn_mfma_f32_32x32x16_bf16(PAF(0),VFR(0),o[0],0,0,0), C0,0); \
    GAPB(o[1]=__builtin_amdgcn_mfma_f32_32x32x16_bf16(PAF(0),VFR(4),o[1],0,0,0), C0,4); \
    KRD(GL,0); GAPB(o[0]=__builtin_amdgcn_mfma_f32_32x32x16_bf16(PAF(1),VFR(1),o[0],0,0,0), C0,8); \
    KRD(GL,1); GAPB(o[1]=__builtin_amdgcn_mfma_f32_32x32x16_bf16(PAF(1),VFR(5),o[1],0,0,0), C0,12); \
    KRD(GL,2); GAPB(o[0]=__builtin_amdgcn_mfma_f32_32x32x16_bf16(PAF(2),VFR(2),o[0],0,0,0), C1,0); \
    KRD(GL,3); GAPB(o[1]=__builtin_amdgcn_mfma_f32_32x32x16_bf16(PAF(2),VFR(6),o[1],0,0,0), C1,4); \
    GAPB(o[0]=__builtin_amdgcn_mfma_f32_32x32x16_bf16(PAF(3),VFR(3),o[0],0,0,0), C1,8); \
    GAPB(o[1]=__builtin_amdgcn_mfma_f32_32x32x16_bf16(PAF(3),VFR(7),o[1],0,0,0), C1,12); \
    }while(0)
  int t=1;
  #undef CMASK
  #define CMASK(P0,P1,t) do{}while(0)
  for(;t+5<NT;t+=2){
    STEP(pB0,pB1,pA0,pA1,t,true,true,true);     WAIT_BAR(2); RESC(); ROT();
    STEP(pA0,pA1,pB0,pB1,t+1,true,true,true);   WAIT_BAR(2); RESC(); ROT();
  }
  #undef CMASK
  #define CMASK(P0,P1,t) do{int jb_=(t)-(NT-4); if(jb_>=0)cmask(P0,P1,jb_,qrel,hi);}while(0)
  #define ENDW(tt) do{ if((tt)+3<NT){WAIT_BAR(2);} else if((tt)+2<NT){WAIT_BAR(1);} else {WAIT_BAR(0);} }while(0)
  for(;t+1<NT;t+=2){
    STEP(pB0,pB1,pA0,pA1,t,(t+3<NT),(t+1<NT),(t+1<NT));       ENDW(t);   RESC(); ROT();
    STEP(pA0,pA1,pB0,pB1,t+1,(t+4<NT),(t+2<NT),(t+2<NT));     ENDW(t+1); RESC(); ROT();
  }
  STEP(pB0,pB1,pA0,pA1,NT-1,false,false,false); RESC();
  { float sacc=pB0[0]+pB0[1]; _Pragma("unroll") for(int r=2;r<16;++r)sacc+=pB0[r]; _Pragma("unroll") for(int r=0;r<16;++r)sacc+=pB1[r]; l_reg+=sacc;
    pw0=(u32x4){PKW(pB0,0),PKW(pB0,2),PKW(pB0,4),PKW(pB0,6)};pw1=(u32x4){PKW(pB0,8),PKW(pB0,10),PKW(pB0,12),PKW(pB0,14)};pw2=(u32x4){PKW(pB1,0),PKW(pB1,2),PKW(pB1,4),PKW(pB1,6)};pw3=(u32x4){PKW(pB1,8),PKW(pB1,10),PKW(pB1,12),PKW(pB1,14)};
    SBAR(); pv(o,vb0+sl_cur,PAF(0),PAF(1),PAF(2),PAF(3)); }
  #undef PKW
  #undef PAF
  #undef VFR
  #undef PIN
  #undef MX3
  #undef GAPA
  #undef GAPB
  #undef EX
  #undef VRD
  #undef KRD
  #undef STEP
  #undef ENDW
  {auto rr=__builtin_amdgcn_permlane32_swap(__float_as_uint(l_reg),__float_as_uint(l_reg),false,false);l_reg=__uint_as_float(rr[0])+__uint_as_float(rr[1]);}
  if(hi==0)wsf[32+r32]=l_reg;asm volatile("s_waitcnt lgkmcnt(0)":::"memory");
  float rli[16];
  #pragma unroll
  for(int r=0;r<16;++r)rli[r]=__builtin_amdgcn_rcpf(wsf[32+crow(r,hi)]);
  bf16*Ow=O+(rowbase+q0+wid*QBLK)*DM+hv*D;
  { bf16*stg=(bf16*)(shm+LDS_OST)+wid*2048;
    #pragma unroll
    for(int r=0;r<16;++r){const int orow=crow(r,hi);
      #pragma unroll
      for(int d0=0;d0<2;++d0)stg[orow*64+d0*32+r32]=__float2bfloat16(o[d0][r]*rli[r]);}
    asm volatile("s_waitcnt lgkmcnt(0)":::"memory");
    #pragma unroll
    for(int i=0;i<4;++i){const int row=i*8+(lane>>3),ch=lane&7; const u32x4 v=*(const u32x4*)(stg+row*64+ch*8); ATTN_STORE16(Ow+(long)row*DM+ch*8,v);} }
  asm volatile("s_waitcnt lgkmcnt(0)\n\ts_barrier":::"memory");
  #undef DMA_K
  #undef DMA_V
  #undef CMASK
  #undef START
  #undef RESC
  #undef ROT
}
constexpr int ATTN_LDS_BYTES=LDS_BYTES;
#undef SBAR
#undef WAIT_BAR
}
#include <hip/hip_cooperative_groups.h>
namespace cg = cooperative_groups;
#define LAS __attribute__((address_space(3)))
typedef unsigned short bf16;
typedef unsigned v4u __attribute__((ext_vector_type(4)));
typedef unsigned v2u __attribute__((ext_vector_type(2)));
typedef float f32x4 __attribute__((ext_vector_type(4)));
typedef short bf16x8 __attribute__((ext_vector_type(8)));

constexpr int M = 16384, DM = 2048, DFF = 5632, SEQ = 2048, NB = 8;
constexpr int NPROJ = 7168;
constexpr float EPS = 1e-6f;
constexpr float LOG2E = 1.4426950408889634f;
constexpr size_t MiB = 1u << 20;
constexpr size_t WS_ROPE = 0;
constexpr size_t WS_BAR = 256 * 1024, WS_BAR_BYTES = 16384;
constexpr size_t WS_SS = 320 * 1024;
constexpr size_t WS_CNT = 576 * 1024;
constexpr size_t WS_ZERO_BYTES = 336 * 1024;
constexpr size_t WS_WFI = 1 * MiB;
constexpr size_t WS_WFO = 45 * MiB;
constexpr size_t WS_WIN = 67 * MiB;
constexpr size_t WS_WPA = 111 * MiB, WS_WPR = 115 * MiB, WS_WWO = 119 * MiB;
constexpr size_t WS_H = 127 * MiB;
constexpr size_t WS_BIG = 191 * MiB;
constexpr size_t WS_Y = 415 * MiB;
constexpr size_t WS_OR = 479 * MiB;
constexpr size_t WS_END = 511 * MiB;
constexpr size_t PBUF = (size_t)M * 1024;
enum { PB_QA = 0, PB_KA = 1, PB_VA = 2, PB_QR = 3, PB_LF = 4, PB_IO = 5, PB_G = 6 };
constexpr int RING_BYTES = 131072, LDS_BYTES = 147456;

__device__ __forceinline__ float fexp(float x) { return __builtin_amdgcn_exp2f(x * LOG2E); }
__device__ __forceinline__ float sigm(float x) { return __builtin_amdgcn_rcpf(1.f + fexp(-x)); }
__device__ __forceinline__ float silu(float x) { return x * sigm(x); }
typedef float f32x2_m __attribute__((ext_vector_type(2))); typedef __bf16 bf16x2_m __attribute__((ext_vector_type(2)));
__device__ __forceinline__ unsigned pkbf(float lo, float hi) { const f32x2_m v = {lo, hi}; const bf16x2_m b = __builtin_convertvector(v, bf16x2_m); return __builtin_bit_cast(unsigned, b); }
__device__ __forceinline__ float bflo(unsigned w) { return __builtin_bit_cast(float, w << 16); }
__device__ __forceinline__ float bfhi(unsigned w) { return __builtin_bit_cast(float, w & 0xffff0000u); }
__device__ __forceinline__ unsigned pkh(float lo, float hi) { const _Float16 a = (_Float16)lo, b = (_Float16)hi; return (unsigned)__builtin_bit_cast(unsigned short, a) | ((unsigned)__builtin_bit_cast(unsigned short, b) << 16); }
__device__ __forceinline__ float wave_sum(float v) {
#pragma unroll
    for (int o = 1; o < 64; o <<= 1) v += __shfl_xor(v, o);
    return v;
}

namespace epi {
using pg8::Unit; using pg8::BM; using pg8::HALF;
template <int RSM> __device__ __forceinline__ float row_scale(const float* p, int row) { const float v = __hip_atomic_load(p + row, __ATOMIC_RELAXED, __HIP_MEMORY_SCOPE_AGENT); return RSM == 0 ? v : 1.0f / sqrtf(v * (1.f / DM) + EPS); }
template <int RSM> struct EpiSwiglu { static constexpr bool PERM = true, AFTER_DRAIN = false; bf16* O; int ldc; const float* rs;
    __device__ __forceinline__ void operator()(const f32x4 (&acc)[2][2][4][2], const Unit& u, int wr, int wc, int fr, int fq) const {
        const int row0 = u.pm * BM + wr * 64 + fr, col0 = u.pn * HALF + wc * 32 + 8 * fq;
#pragma unroll
        for (int ai = 0; ai < 2; ++ai)
#pragma unroll
            for (int m = 0; m < 4; ++m) { const int row = row0 + ai * HALF + m * 16; bf16* rowp = O + (size_t)row * ldc + col0; const float sc = row_scale<RSM>(rs, row);
                const f32x4 g0 = acc[ai][0][m][0] * sc, g1 = acc[ai][0][m][1] * sc, u0 = acc[ai][1][m][0] * sc, u1 = acc[ai][1][m][1] * sc;
                v4u w; w.x = pkbf(silu(g0[0]) * u0[0], silu(g0[1]) * u0[1]); w.y = pkbf(silu(g0[2]) * u0[2], silu(g0[3]) * u0[3]);
                w.z = pkbf(silu(g1[0]) * u1[0], silu(g1[1]) * u1[1]); w.w = pkbf(silu(g1[2]) * u1[2], silu(g1[3]) * u1[3]);
                *(v4u*)rowp = w; }
    }
};
template <int NORM, int SSI, bool HALFSC> struct EpiResid { static constexpr bool PERM = false, AFTER_DRAIN = false; static constexpr int ldc = DM; const float* base; float* out; unsigned char* wsb;
    __device__ __forceinline__ void operator()(const f32x4 (&acc)[2][2][4][2], const Unit& u, int wr, int wc, int fr, int fq) const {
        const int row0 = u.pm * BM + wr * 64 + fr, col0 = u.pn * BM + wc * 32 + 4 * fq; const float scale = HALFSC ? 0.5f : 1.0f;
        bf16* xb = (bf16*)(wsb + WS_H); float* ss = (float*)(wsb + WS_SS) + (size_t)SSI * M;
#pragma unroll
        for (int ai = 0; ai < 2; ++ai) { f32x4 pre[4][2][2];
#pragma unroll
            for (int m = 0; m < 4; ++m)
#pragma unroll
                for (int bj = 0; bj < 2; ++bj)
#pragma unroll
                    for (int n = 0; n < 2; ++n) pre[m][bj][n] = *(const f32x4*)(base + (size_t)(row0 + ai * HALF + m * 16) * ldc + col0 + bj * HALF + n * 16);
            asm volatile("" ::: "memory");
#pragma unroll
            for (int m = 0; m < 4; ++m) { const int row = row0 + ai * HALF + m * 16; const size_t off = (size_t)row * ldc + col0; float sq = 0.f;
#pragma unroll
                for (int bj = 0; bj < 2; ++bj)
#pragma unroll
                    for (int n = 0; n < 2; ++n) { const size_t p = off + bj * HALF + n * 16; const f32x4 o = pre[m][bj][n] + acc[ai][bj][m][n] * scale; *(f32x4*)(out + p) = o;
                        if (NORM == 1) *(v2u*)(xb + p) = (v2u){pkbf(o[0], o[1]), pkbf(o[2], o[3])};
                        if (NORM) sq += (o[0] * o[0] + o[1] * o[1]) + (o[2] * o[2] + o[3] * o[3]); }
                if (NORM) { sq += __shfl_xor(sq, 16); sq += __shfl_xor(sq, 32); if (fq == 0) __hip_atomic_fetch_add(ss + row, sq, __ATOMIC_RELAXED, __HIP_MEMORY_SCOPE_AGENT); } } }
    }
};
template <int MODE> struct EpiGate { static constexpr bool PERM = true, AFTER_DRAIN = false; bf16* T1; const unsigned char* gt;
    __device__ __forceinline__ void operator()(const f32x4 (&acc)[2][2][4][2], const Unit& u, int wr, int wc, int fr, int fq) const {
        const int row0 = u.pm * BM + wr * 64 + fr, col0 = u.pn * BM + wc * 32 + 8 * fq;
#pragma unroll
        for (int ai = 0; ai < 2; ++ai) { v2u gq[4][2]; v4u tq[4][2];
#pragma unroll
            for (int m = 0; m < 4; ++m)
#pragma unroll
                for (int bj = 0; bj < 2; ++bj) { const size_t p = (size_t)(row0 + ai * HALF + m * 16) * DM + col0 + bj * HALF; gq[m][bj] = *(const v2u*)(gt + p); if (MODE == 1) tq[m][bj] = *(const v4u*)(T1 + p); }
            asm volatile("" ::: "memory");
#pragma unroll
            for (int m = 0; m < 4; ++m)
#pragma unroll
                for (int bj = 0; bj < 2; ++bj) { const size_t p = (size_t)(row0 + ai * HALF + m * 16) * DM + col0 + bj * HALF;
                    const f32x4 a0 = acc[ai][bj][m][0], a1 = acc[ai][bj][m][1]; const v2u g = gq[m][bj]; const float s = 1.f / 255.f;
                    float v[8] = {a0[0] * ((float)((g.x >> 0) & 0xffu) * s), a0[1] * ((float)((g.x >> 8) & 0xffu) * s), a0[2] * ((float)((g.x >> 16) & 0xffu) * s), a0[3] * ((float)((g.x >> 24) & 0xffu) * s),
                                  a1[0] * ((float)((g.y >> 0) & 0xffu) * s), a1[1] * ((float)((g.y >> 8) & 0xffu) * s), a1[2] * ((float)((g.y >> 16) & 0xffu) * s), a1[3] * ((float)((g.y >> 24) & 0xffu) * s)};
                    if (MODE == 1) { const v4u t = tq[m][bj];
                        v[0] += bflo(t.x); v[1] += bfhi(t.x); v[2] += bflo(t.y); v[3] += bfhi(t.y); v[4] += bflo(t.z); v[5] += bfhi(t.z); v[6] += bflo(t.w); v[7] += bfhi(t.w); }
                    v4u w; w.x = pkbf(v[0], v[1]); w.y = pkbf(v[2], v[3]); w.z = pkbf(v[4], v[5]); w.w = pkbf(v[6], v[7]);
                    *(v4u*)(T1 + p) = w; } }
    }
};
struct EpiMix { static constexpr bool PERM = true, AFTER_DRAIN = false; unsigned char* wsb; const float* lbraw;
    __device__ __forceinline__ void operator()(const f32x4 (&acc)[2][2][4][2], const Unit& u, int wr, int wc, int fr, int fq) const {
        bf16* P = (bf16*)(wsb + WS_BIG); const float* ropeC = (const float*)(wsb + WS_ROPE); const float* ropeS = ropeC + SEQ * 8; const float* rs = (const float*)(wsb + WS_SS) + M;
        const int reg = u.pn >> 2; bf16* base = P + (size_t)reg * PBUF;
        const int row0 = u.pm * BM + wr * 64 + fr, lc0 = (u.pn & 3) * 256 + wc * 32 + 8 * fq;
        const bool rope = (reg <= 1) && ((wc & 1) == 0);
        const float qs = (reg == 0) ? attn_body::C2 : 1.f;
        float lb[2][8];
        if (reg == PB_LF) {
#pragma unroll
            for (int bj = 0; bj < 2; ++bj)
#pragma unroll
                for (int j = 0; j < 8; ++j) { const int c = lc0 + bj * HALF + j; lb[bj][j] = sigm(lbraw[c] - lbraw[1024 + c]); }
        }
#pragma unroll
        for (int ai = 0; ai < 2; ++ai)
#pragma unroll
            for (int m = 0; m < 4; ++m) { const int row = row0 + ai * HALF + m * 16; const float sc = row_scale<1>(rs, row);
                f32x4 c0, c1, s0, s1;
                if (rope) { const int pos = row & (SEQ - 1); c0 = *(const f32x4*)(ropeC + pos * 8); c1 = *(const f32x4*)(ropeC + pos * 8 + 4); s0 = *(const f32x4*)(ropeS + pos * 8); s1 = *(const f32x4*)(ropeS + pos * 8 + 4); }
#pragma unroll
                for (int bj = 0; bj < 2; ++bj) { const f32x4 a0 = acc[ai][bj][m][0] * sc, a1 = acc[ai][bj][m][1] * sc;
                    float v[8] = {a0[0], a0[1], a0[2], a0[3], a1[0], a1[1], a1[2], a1[3]};
                    v4u w;
                    if (reg >= 7) {
                        unsigned g0 = 0u, g1 = 0u;
                        g0 = __builtin_amdgcn_cvt_pk_u8_f32(__builtin_rintf(sigm(v[0]) * 255.f), 0, g0); g0 = __builtin_amdgcn_cvt_pk_u8_f32(__builtin_rintf(sigm(v[1]) * 255.f), 1, g0);
                        g0 = __builtin_amdgcn_cvt_pk_u8_f32(__builtin_rintf(sigm(v[2]) * 255.f), 2, g0); g0 = __builtin_amdgcn_cvt_pk_u8_f32(__builtin_rintf(sigm(v[3]) * 255.f), 3, g0);
                        g1 = __builtin_amdgcn_cvt_pk_u8_f32(__builtin_rintf(sigm(v[4]) * 255.f), 0, g1); g1 = __builtin_amdgcn_cvt_pk_u8_f32(__builtin_rintf(sigm(v[5]) * 255.f), 1, g1);
                        g1 = __builtin_amdgcn_cvt_pk_u8_f32(__builtin_rintf(sigm(v[6]) * 255.f), 2, g1); g1 = __builtin_amdgcn_cvt_pk_u8_f32(__builtin_rintf(sigm(v[7]) * 255.f), 3, g1);
                        unsigned char* gb = wsb + WS_WFI + (reg >= 9 ? (size_t)M * DM : (size_t)0);
                        *(v2u*)(gb + (size_t)row * DM + ((u.pn - 28) & 7) * 256 + wc * 32 + 8 * fq + bj * HALF) = (v2u){g0, g1};
                        continue; }
                    if (reg <= 1) {
                        if (rope) { const float cs[8] = {c0[0], c0[1], c0[2], c0[3], c1[0], c1[1], c1[2], c1[3]}; const float sn[8] = {s0[0], s0[1], s0[2], s0[3], s1[0], s1[1], s1[2], s1[3]};
#pragma unroll
                            for (int j = 0; j < 8; ++j) { const float o = __shfl_xor(v[j], 16); if (fq == 0) v[j] = v[j] * cs[j] - o * sn[j]; else if (fq == 1) v[j] = v[j] * cs[j] + o * sn[j]; } }
#pragma unroll
                        for (int j = 0; j < 8; ++j) v[j] *= qs;
                    } else if (reg == PB_QR || reg == PB_G) {
#pragma unroll
                        for (int j = 0; j < 8; ++j) v[j] = silu(v[j]);
                    }
                    if (reg == PB_LF) {
#pragma unroll
                        for (int j = 0; j < 8; ++j) v[j] = (1.f - lb[bj][j]) * sigm(-v[j]);
                        w.x = pkh(v[0], v[1]); w.y = pkh(v[2], v[3]); w.z = pkh(v[4], v[5]); w.w = pkh(v[6], v[7]);
                    } else { w.x = pkbf(v[0], v[1]); w.y = pkbf(v[2], v[3]); w.z = pkbf(v[4], v[5]); w.w = pkbf(v[6], v[7]); }
                    *(v4u*)(base + (size_t)row * 1024 + lc0 + bj * HALF) = w; } }
    }
};
struct EpiFinal { static constexpr bool PERM = false, AFTER_DRAIN = false; static constexpr int ldc = DM; float* out; unsigned char* wsb; const float* wfin;
    __device__ __forceinline__ void operator()(f32x4 (&acc)[2][2][4][2], const Unit& u, int wr, int wc, int fr, int fq) const {
        const int row0 = u.pm * BM + wr * 64 + fr, col0 = u.pn * BM + wc * 32 + 4 * fq;
        float* ss = (float*)(wsb + WS_SS) + (size_t)3 * M; unsigned* cnt = (unsigned*)(wsb + WS_CNT) + 64 * u.pm;
#pragma unroll
        for (int ai = 0; ai < 2; ++ai) { f32x4 pre[4][2][2];
#pragma unroll
            for (int m = 0; m < 4; ++m)
#pragma unroll
                for (int bj = 0; bj < 2; ++bj)
#pragma unroll
                    for (int n = 0; n < 2; ++n) pre[m][bj][n] = *(const f32x4*)(out + (size_t)(row0 + ai * HALF + m * 16) * ldc + col0 + bj * HALF + n * 16);
            asm volatile("" ::: "memory");
#pragma unroll
            for (int m = 0; m < 4; ++m) { const int row = row0 + ai * HALF + m * 16; float sq = 0.f;
#pragma unroll
                for (int bj = 0; bj < 2; ++bj)
#pragma unroll
                    for (int n = 0; n < 2; ++n) { const f32x4 o = pre[m][bj][n] + acc[ai][bj][m][n] * 0.5f; acc[ai][bj][m][n] = o;
                        sq += (o[0] * o[0] + o[1] * o[1]) + (o[2] * o[2] + o[3] * o[3]); }
                sq += __shfl_xor(sq, 16); sq += __shfl_xor(sq, 32); if (fq == 0) __hip_atomic_fetch_add(ss + row, sq, __ATOMIC_RELAXED, __HIP_MEMORY_SCOPE_AGENT); } }
        asm volatile("s_waitcnt vmcnt(0)" ::: "memory");
        if (fr == 0 && fq == 0) { __hip_atomic_fetch_add(cnt, 1u, __ATOMIC_RELAXED, __HIP_MEMORY_SCOPE_AGENT);
            unsigned spins = 0; while (__hip_atomic_load(cnt, __ATOMIC_RELAXED, __HIP_MEMORY_SCOPE_AGENT) < 64u && ++spins < (1u << 22)) __builtin_amdgcn_s_sleep(2); }
        asm volatile("" ::: "memory");
#pragma unroll
        for (int ai = 0; ai < 2; ++ai)
#pragma unroll
            for (int m = 0; m < 4; ++m) { const int row = row0 + ai * HALF + m * 16; const size_t off = (size_t)row * ldc + col0; const float rs = row_scale<1>(ss, row);
#pragma unroll
                for (int bj = 0; bj < 2; ++bj)
#pragma unroll
                    for (int n = 0; n < 2; ++n) { const size_t p = off + bj * HALF + n * 16; const f32x4 w4 = *(const f32x4*)(wfin + col0 + bj * HALF + n * 16); *(f32x4*)(out + p) = acc[ai][bj][m][n] * rs * w4; } }
    }
};
struct PanelOrder { int v;
    __host__ __device__ bool next(int i, Unit& u) const { if (i >= 2) return false; u.pm = 8 * (v >> 5) + 4 * i + ((v >> 3) & 3); u.pn = v & 7; return true; }
    __device__ __forceinline__ void a_ready(const Unit&) const {}
    __device__ __forceinline__ void done(const Unit&) const {}
};
}

namespace hg {
constexpr int QS = 136, TS = 72;
constexpr int OFF_QG = 0, OFF_KN = 17408, OFF_KLT = 34816, OFF_VT = 53248, OFF_AM = 57856, OFF_ST = 67072, OFF_TOT = 75776, OFF_GL = 77824, HG_LDS = 78336;
#define HG_MFMA(x, y, c) __builtin_amdgcn_mfma_f32_16x16x32_bf16((x), (y), (c), 0, 0, 0)
#define HG_LD8(off) (*(const LAS bf16x8*)(lds + (off)))
#define HG_BAR() asm volatile("s_waitcnt lgkmcnt(0)\n\ts_barrier" ::: "memory")
__device__ __forceinline__ void hgrn_unit(LAS unsigned char* lds, int b, int h, int vs, const bf16* QR, const _Float16* LF, const bf16* IO, bf16* OR_) {
    int tid_ = threadIdx.x; asm volatile("" : "+v"(tid_));
    const int tid = tid_, lane = tid & 63, wid = __builtin_amdgcn_readfirstlane(tid >> 6), fr = lane & 15, fq = lane >> 4;
    const size_t rowbase = (size_t)b * SEQ;
    constexpr int NCH = SEQ / 64;
    if (wid < 4) {
        const int ew = wid, t0 = 16 * ew;
        const unsigned* lp = (const unsigned*)(LF + (rowbase + t0) * 1024 + h * 128) + lane;
        const unsigned* qp = (const unsigned*)(QR + (rowbase + t0) * 1024 + h * 128) + lane;
        const int et = ew * 64 + lane, vrow = et >> 2, c8 = et & 3;
        const v4u* vp = (const v4u*)(IO + (rowbase + vrow) * 1024 + h * 128 + vs * 32 + 8 * c8);
        unsigned clf[16], cq[16], nlf[16], nq[16]; v4u cv, nv;
#pragma unroll
        for (int i = 0; i < 16; ++i) { clf[i] = lp[i * 512]; cq[i] = qp[i * 512]; nlf[i] = 0u; nq[i] = 0u; }
        cv = *vp; nv = cv;
        for (int n = 0; n < NCH; ++n) {
            if (n + 1 < NCH) { lp += 64 * 512; qp += 64 * 512; vp += 64 * 128;
#pragma unroll
                for (int i = 0; i < 16; ++i) { nlf[i] = lp[i * 512]; nq[i] = qp[i * 512]; }
                nv = *vp; }
            float qa[2][16], kb[2][16], tot[2];
#pragma unroll
            for (int e = 0; e < 2; ++e) { float run = 1.f;
#pragma unroll
                for (int i = 0; i < 16; ++i) { const unsigned short hb = (unsigned short)(e ? (clf[i] >> 16) : (clf[i] & 0xffffu)); const float kk = (float)__builtin_bit_cast(_Float16, hb);
                    run *= (1.f - kk); const float q = e ? bfhi(cq[i]) : bflo(cq[i]);
                    qa[e][i] = q * run; kb[e][i] = kk * __builtin_amdgcn_rcpf(run); }
                tot[e] = run; }
            ((LAS f32x2_m*)(lds + OFF_TOT))[ew * 64 + lane] = (f32x2_m){tot[0], tot[1]};
            HG_BAR();
            float eoff[2], ieoff[2], eGl[2];
            { const f32x2_m t0v = ((LAS f32x2_m*)(lds + OFF_TOT))[lane], t1v = ((LAS f32x2_m*)(lds + OFF_TOT))[64 + lane], t2v = ((LAS f32x2_m*)(lds + OFF_TOT))[128 + lane], t3v = ((LAS f32x2_m*)(lds + OFF_TOT))[192 + lane];
#pragma unroll
              for (int e = 0; e < 2; ++e) { const float off = (ew > 0 ? t0v[e] : 1.f) * (ew > 1 ? t1v[e] : 1.f) * (ew > 2 ? t2v[e] : 1.f);
                  eoff[e] = off; ieoff[e] = __builtin_amdgcn_rcpf(off); eGl[e] = (t0v[e] * t1v[e]) * (t2v[e] * t3v[e]); } }
            unsigned klp[2][8];
#pragma unroll
            for (int i = 0; i < 16; i += 2) { float kl[2][2];
#pragma unroll
                for (int d = 0; d < 2; ++d) { const float kn0 = kb[0][i + d] * ieoff[0], kn1 = kb[1][i + d] * ieoff[1];
                    ((LAS unsigned*)(lds + OFF_QG))[(t0 + i + d) * (QS / 2) + lane] = pkbf(qa[0][i + d] * eoff[0], qa[1][i + d] * eoff[1]);
                    ((LAS unsigned*)(lds + OFF_KN))[(t0 + i + d) * (QS / 2) + lane] = pkbf(kn0, kn1);
                    kl[0][d] = kn0 * eGl[0]; kl[1][d] = kn1 * eGl[1]; }
                klp[0][i >> 1] = pkbf(kl[0][0], kl[0][1]); klp[1][i >> 1] = pkbf(kl[1][0], kl[1][1]); }
#pragma unroll
            for (int e = 0; e < 2; ++e) { const int k = 2 * lane + e;
                *(LAS v4u*)(lds + OFF_KLT + (k * TS + t0) * 2) = (v4u){klp[e][0], klp[e][1], klp[e][2], klp[e][3]};
                *(LAS v4u*)(lds + OFF_KLT + (k * TS + t0 + 8) * 2) = (v4u){klp[e][4], klp[e][5], klp[e][6], klp[e][7]}; }
            if (ew == 0) ((LAS f32x2_m*)(lds + OFF_GL))[lane] = (f32x2_m){eGl[0], eGl[1]};
            { LAS bf16* vt = (LAS bf16*)(lds + OFF_VT) + (8 * c8) * TS + vrow;
              vt[0 * TS] = (bf16)(cv.x & 0xffffu); vt[1 * TS] = (bf16)(cv.x >> 16); vt[2 * TS] = (bf16)(cv.y & 0xffffu); vt[3 * TS] = (bf16)(cv.y >> 16);
              vt[4 * TS] = (bf16)(cv.z & 0xffffu); vt[5 * TS] = (bf16)(cv.z >> 16); vt[6 * TS] = (bf16)(cv.w & 0xffffu); vt[7 * TS] = (bf16)(cv.w >> 16); }
#pragma unroll
            for (int i = 0; i < 16; ++i) { clf[i] = nlf[i]; cq[i] = nq[i]; }
            cv = nv;
            HG_BAR();
        }
        HG_BAR(); HG_BAR();
    } else {
        const int mw = wid - 4;
        for (int i = tid - 256; i < 32 * QS / 2; i += 256) ((LAS unsigned*)(lds + OFF_ST))[i] = 0u;
        f32x4 sacc[2][2];
#pragma unroll
        for (int ki = 0; ki < 2; ++ki)
#pragma unroll
            for (int vj = 0; vj < 2; ++vj) sacc[ki][vj] = (f32x4){0.f, 0.f, 0.f, 0.f};
        bf16* op = OR_ + (rowbase + 16 * mw + fr) * 1024 + h * 128 + vs * 32 + 4 * fq;
        HG_BAR(); HG_BAR();
        for (int c = 0; c < NCH; ++c) {
            bf16x8 qgf[4], knf[4][4], stf[2][4], vtf[2][2], klf[2][2]; f32x4 glv[2];
#pragma unroll
            for (int kk = 0; kk < 4; ++kk) qgf[kk] = HG_LD8(OFF_QG + ((16 * mw + fr) * QS + 32 * kk + 8 * fq) * 2);
#pragma unroll
            for (int sj = 0; sj < 4; ++sj)
#pragma unroll
                for (int kk = 0; kk < 4; ++kk) knf[sj][kk] = (sj <= mw) ? HG_LD8(OFF_KN + ((16 * sj + fr) * QS + 32 * kk + 8 * fq) * 2) : qgf[kk];
#pragma unroll
            for (int vj = 0; vj < 2; ++vj) {
#pragma unroll
                for (int kk = 0; kk < 4; ++kk) stf[vj][kk] = HG_LD8(OFF_ST + ((16 * vj + fr) * QS + 32 * kk + 8 * fq) * 2);
#pragma unroll
                for (int ss = 0; ss < 2; ++ss) vtf[vj][ss] = HG_LD8(OFF_VT + ((16 * vj + fr) * TS + 32 * ss + 8 * fq) * 2); }
#pragma unroll
            for (int ki = 0; ki < 2; ++ki) { const int kg = 2 * mw + ki; glv[ki] = *(const LAS f32x4*)(lds + OFF_GL + (16 * kg + 4 * fq) * 4);
#pragma unroll
                for (int ss = 0; ss < 2; ++ss) klf[ki][ss] = HG_LD8(OFF_KLT + ((16 * kg + fr) * TS + 32 * ss + 8 * fq) * 2); }
            f32x4 a[4], o[2];
#pragma unroll
            for (int sj = 0; sj < 4; ++sj) { a[sj] = (f32x4){0.f, 0.f, 0.f, 0.f};
                if (sj <= mw) {
#pragma unroll
                    for (int kk = 0; kk < 4; ++kk) a[sj] = HG_MFMA(knf[sj][kk], qgf[kk], a[sj]);
                    if (sj == mw) {
#pragma unroll
                        for (int r = 0; r < 4; ++r) if (4 * fq + r > fr) a[sj][r] = 0.f; }
                } }
#pragma unroll
            for (int vj = 0; vj < 2; ++vj) { o[vj] = (f32x4){0.f, 0.f, 0.f, 0.f};
#pragma unroll
                for (int kk = 0; kk < 4; ++kk) o[vj] = HG_MFMA(stf[vj][kk], qgf[kk], o[vj]); }
#pragma unroll
            for (int ki = 0; ki < 2; ++ki)
#pragma unroll
                for (int vj = 0; vj < 2; ++vj) { sacc[ki][vj] = sacc[ki][vj] * glv[ki]; sacc[ki][vj] = HG_MFMA(klf[ki][0], vtf[vj][0], sacc[ki][vj]); sacc[ki][vj] = HG_MFMA(klf[ki][1], vtf[vj][1], sacc[ki][vj]); }
#pragma unroll
            for (int sj = 0; sj < 4; ++sj) *(LAS v2u*)(lds + OFF_AM + ((16 * mw + fr) * TS + 16 * sj + 4 * fq) * 2) = (v2u){pkbf(a[sj][0], a[sj][1]), pkbf(a[sj][2], a[sj][3])};
            HG_BAR();
            bf16x8 amf[2];
#pragma unroll
            for (int ss = 0; ss < 2; ++ss) amf[ss] = HG_LD8(OFF_AM + ((16 * mw + fr) * TS + 32 * ss + 8 * fq) * 2);
#pragma unroll
            for (int ki = 0; ki < 2; ++ki)
#pragma unroll
                for (int vj = 0; vj < 2; ++vj) *(LAS v2u*)(lds + OFF_ST + ((16 * vj + fr) * QS + 16 * (2 * mw + ki) + 4 * fq) * 2) = (v2u){pkbf(sacc[ki][vj][0], sacc[ki][vj][1]), pkbf(sacc[ki][vj][2], sacc[ki][vj][3])};
#pragma unroll
            for (int vj = 0; vj < 2; ++vj) {
#pragma unroll
                for (int ss = 0; ss < 2; ++ss) if (32 * ss <= 16 * mw + 15) o[vj] = HG_MFMA(vtf[vj][ss], amf[ss], o[vj]);
                *(v2u*)(op + (size_t)c * 64 * 1024 + 16 * vj) = (v2u){pkbf(o[vj][0], o[vj][1]), pkbf(o[vj][2], o[vj][3])}; }
            HG_BAR();
        }
    }
}
#undef HG_MFMA
#undef HG_LD8
}

__device__ __forceinline__ void tr_item(const float* W, const float* nw, int K, int N, bf16* WT, int k0, int n0, int drow0, LAS float* scr, int lane) {
    { const int r = lane >> 3, c4 = lane & 7; f32x4 v[8];
#pragma unroll
      for (int i = 0; i < 8; ++i) v[i] = *(const f32x4*)(W + (size_t)(k0 + 8 * i + r) * N + n0 + 4 * c4);
#pragma unroll
      for (int i = 0; i < 8; ++i) { LAS float* d = scr + (8 * i + r) * 33 + 4 * c4; const float s = nw ? nw[k0 + 8 * i + r] : 1.f; d[0] = v[i].x * s; d[1] = v[i].y * s; d[2] = v[i].z * s; d[3] = v[i].w * s; } }
    asm volatile("s_waitcnt lgkmcnt(0)" ::: "memory");
    const int c = lane & 7;
#pragma unroll
    for (int j = 0; j < 4; ++j) { const int n = (lane >> 3) + 8 * j; const LAS float* s = scr + (8 * c) * 33 + n;
        v4u o; o.x = pkbf(s[0 * 33], s[1 * 33]); o.y = pkbf(s[2 * 33], s[3 * 33]); o.z = pkbf(s[4 * 33], s[5 * 33]); o.w = pkbf(s[6 * 33], s[7 * 33]);
        *(v4u*)(WT + (size_t)(drow0 + n) * K + k0 + 8 * c) = o; }
    asm volatile("s_waitcnt lgkmcnt(0)" ::: "memory");
}
template <int MODE> __device__ __forceinline__ void conv_mat(const float* W, const float* nw, int K, int N, bf16* WT, LAS float* scr, int gw, int NGW, int lane) {
    const int nblk = N / 32, nitems = (K / 64) * nblk;
    for (int it = gw; it < nitems; it += NGW) { const int kb = it / nblk, nb = it % nblk, n0 = 32 * nb; int d = n0;
        if (MODE == 1) { d = (n0 < DFF) ? 256 * (n0 / 128) + (n0 % 128) : 256 * ((n0 - DFF) / 128) + 128 + ((n0 - DFF) % 128); }
        tr_item(W, nw, K, N, WT, 64 * kb, n0, d, scr, lane); }
}
__device__ __forceinline__ void prep_rows_bf16(const float* X, float* rs, bf16* Hout, int gw, int NGW, int lane) {
    const bool xcd_deal = (NGW == 2048);
    for (int it = 0, m = xcd_deal ? gw * 8 : gw; m < M && (!xcd_deal || it < 8); ++it, m += xcd_deal ? 1 : NGW) { const f32x4* xr = (const f32x4*)(X + (size_t)m * DM) + lane; f32x4 v[8]; float s = 0.f;
#pragma unroll
        for (int j = 0; j < 8; ++j) { v[j] = xr[64 * j]; s += (v[j].x * v[j].x + v[j].y * v[j].y) + (v[j].z * v[j].z + v[j].w * v[j].w); }
        const float rstd = 1.0f / sqrtf(wave_sum(s) * (1.f / DM) + EPS);
        if (lane == 0) rs[m] = rstd;
        v2u* o = (v2u*)(Hout + (size_t)m * DM) + lane;
#pragma unroll
        for (int j = 0; j < 8; ++j) o[64 * j] = (v2u){pkbf(v[j].x, v[j].y), pkbf(v[j].z, v[j].w)}; }
}
__device__ __forceinline__ void norm_rows_f32_inplace(float* X, const float* ss, const float* w, int gw, int NGW, int lane) {
    for (int m = gw; m < M; m += NGW) { f32x4* xr = (f32x4*)(X + (size_t)m * DM) + lane; f32x4 v[8];
#pragma unroll
        for (int j = 0; j < 8; ++j) v[j] = xr[64 * j];
        const float rstd = epi::row_scale<1>(ss, m);
#pragma unroll
        for (int j = 0; j < 8; ++j) { const f32x4 ww = ((const f32x4*)w)[64 * j + lane]; xr[64 * j] = v[j] * rstd * ww; } }
}
__device__ __forceinline__ void unpack16(const bf16* p, float (&v)[16]) { const v4u a = *(const v4u*)p, b = *(const v4u*)(p + 8);
    v[0] = bflo(a.x); v[1] = bfhi(a.x); v[2] = bflo(a.y); v[3] = bfhi(a.y); v[4] = bflo(a.z); v[5] = bfhi(a.z); v[6] = bflo(a.w); v[7] = bfhi(a.w);
    v[8] = bflo(b.x); v[9] = bfhi(b.x); v[10] = bflo(b.y); v[11] = bfhi(b.y); v[12] = bflo(b.z); v[13] = bfhi(b.z); v[14] = bflo(b.w); v[15] = bfhi(b.w); }
__device__ __forceinline__ void pack16(bf16* p, const float (&v)[16]) {
    *(v4u*)p = (v4u){pkbf(v[0], v[1]), pkbf(v[2], v[3]), pkbf(v[4], v[5]), pkbf(v[6], v[7])}; *(v4u*)(p + 8) = (v4u){pkbf(v[8], v[9]), pkbf(v[10], v[11]), pkbf(v[12], v[13]), pkbf(v[14], v[15])}; }
__device__ __forceinline__ void combine_rows(const bf16* O1, const bf16* O2, const bf16* OR_, const bf16* Gs, bf16* YA, bf16* YR, float lam, const float* subln, const float* gnorm, int gw, int NGW, int lane) {
    const bool xcd_deal = (NGW == 2048);
    float wa[16], wg[16];
#pragma unroll
    for (int i = 0; i < 16; ++i) { wa[i] = subln[16 * (lane & 7) + i] * 0.8f; wg[i] = gnorm[16 * (lane & 7) + i]; }
    for (int it = 0, m = xcd_deal ? gw * 8 : gw; m < M && (!xcd_deal || it < 8); ++it, m += xcd_deal ? 1 : NGW) { const size_t p = (size_t)m * 1024 + 16 * lane;
        float a[16], b2[16], r[16], g[16]; unpack16(O1 + p, a); unpack16(O2 + p, b2); unpack16(OR_ + p, r); unpack16(Gs + p, g);
        float sa = 0.f, sr = 0.f;
#pragma unroll
        for (int i = 0; i < 16; ++i) { a[i] = a[i] - lam * b2[i]; sa += a[i] * a[i]; sr += r[i] * r[i]; }
        sa += __shfl_xor(sa, 1); sa += __shfl_xor(sa, 2); sa += __shfl_xor(sa, 4); sr += __shfl_xor(sr, 1); sr += __shfl_xor(sr, 2); sr += __shfl_xor(sr, 4);
        const float ra = 1.0f / sqrtf(sa * (1.f / 128.f) + EPS), rr = 1.0f / sqrtf(sr * (1.f / 128.f) + EPS);
#pragma unroll
        for (int i = 0; i < 16; ++i) { a[i] = a[i] * ra * wa[i]; r[i] = r[i] * rr * wg[i] * g[i]; }
        pack16(YA + p, a); pack16(YR + p, r); }
}

#define XB_TMO      128
#define XB_XCNT(j)  (256  + 64 * (j))
#define XB_XSUB(j)  (1280 + 64 * (j))
#define XB_XGEN(j)  (2304 + 64 * (j))
#define XB_TOP      3328
#define XB_TOPGEN   3392
#define XCD_BAR_WORDS 3456
#define XB_SPIN_CAP (1u << 18)

__device__ __forceinline__ unsigned xb_ld(unsigned* p)              { return __hip_atomic_load(p, __ATOMIC_RELAXED, __HIP_MEMORY_SCOPE_AGENT); }
__device__ __forceinline__ unsigned xb_add(unsigned* p, unsigned v) { return __hip_atomic_fetch_add(p, v, __ATOMIC_RELAXED, __HIP_MEMORY_SCOPE_AGENT); }
__device__ __forceinline__ unsigned xb_xcc_id() { return (unsigned)__builtin_amdgcn_s_getreg((3 << 11) | 20) & 0xFu; }
#define XB_SPIN(cond, bar) do { unsigned _sp = 0; while (cond) { __builtin_amdgcn_s_sleep(1); \
    if ((++_sp & 255u) == 0u) { if (xb_ld(&(bar)[XB_TMO])) break; if (_sp > XB_SPIN_CAP) { atomicAdd(&(bar)[XB_TMO], 1u); break; } } } } while (0)

struct XcdBarrier {
    unsigned* bar; unsigned x;
    volatile LAS unsigned* st;
};

__device__ __forceinline__ XcdBarrier xcd_barrier_post(unsigned* bar, volatile LAS unsigned* st) {
    XcdBarrier b; b.bar = bar; b.x = xb_xcc_id(); b.st = st;
    if (threadIdx.x == 0) (void)xb_add(&bar[XB_XCNT(b.x)], 1u);
    return b;
}
__device__ __forceinline__ void xcd_barrier_complete(unsigned* bar, unsigned x, unsigned& nloc, unsigned& nx) {
    const unsigned G = gridDim.x * gridDim.y * gridDim.z;
    unsigned sum, cnt, mine, sp = 0u;
    for (;;) {
        sum = 0u; cnt = 0u; mine = 0u;
#pragma unroll
        for (unsigned j = 0; j < 16; ++j) { const unsigned c = xb_ld(&bar[XB_XCNT(j)]); sum += c; cnt += (c > 0u) ? 1u : 0u; mine = (j == x) ? c : mine; }
        if (sum == G) break;
        __builtin_amdgcn_s_sleep(1);
        if ((++sp & 255u) == 0u) { if (xb_ld(&bar[XB_TMO])) break; if (sp > XB_SPIN_CAP) { atomicAdd(&bar[XB_TMO], 1u); break; } }
    }
    nloc = mine > 0u ? mine : 1u; nx = cnt > 0u ? cnt : 1u;
}

__device__ __forceinline__ void xcd_barrier(const XcdBarrier& b) {
    asm volatile("s_waitcnt vmcnt(0)" ::: "memory");
    __syncthreads();
    if (threadIdx.x == 0) {
        unsigned* bar = b.bar;
        __builtin_amdgcn_s_waitcnt(0);
        unsigned nloc = b.st[0], nx = b.st[1];
        if (nloc == 0u) { xcd_barrier_complete(bar, b.x, nloc, nx); b.st[0] = nloc; b.st[1] = nx; }
        const unsigned old = xb_add(&bar[XB_XSUB(b.x)], 1u);
        const unsigned gen = old / nloc;
        if (old + 1u == (gen + 1u) * nloc) {
            __builtin_amdgcn_fence(__ATOMIC_RELEASE, "agent");
            asm volatile("s_waitcnt vmcnt(0)" ::: "memory");
            const unsigned og = xb_add(&bar[XB_TOP], 1u);
            const unsigned tg = og / nx;
            if (og + 1u == (tg + 1u) * nx) xb_add(&bar[XB_TOPGEN], 1u);
            else XB_SPIN(xb_ld(&bar[XB_TOPGEN]) == tg, bar);
            __builtin_amdgcn_fence(__ATOMIC_ACQUIRE, "agent");
            xb_add(&bar[XB_XGEN(b.x)], 1u);
            asm volatile("s_waitcnt vmcnt(0)" ::: "memory");
        } else {
            XB_SPIN(xb_ld(&bar[XB_XGEN(b.x)]) == gen, bar);
            __builtin_amdgcn_fence(__ATOMIC_ACQUIRE, "agent");
            asm volatile("s_waitcnt vmcnt(0)" ::: "memory");
        }
    }
    __syncthreads();
}

struct Args { const float* in[20]; float* out; unsigned char* ws; };
enum { I_X = 0, I_F1N, I_F1I, I_F1O, I_MIXN, I_WIN, I_LQ1, I_LK1, I_LQ2, I_LK2, I_SUBLN, I_LBRAW, I_GNORM, I_WPA, I_WPR, I_WOUT, I_F2N, I_F2I, I_F2O, I_FINN };

__global__ void __launch_bounds__(512, 2) fwd_megakernel(Args a) {
    extern __shared__ __attribute__((aligned(16))) unsigned char lds_raw[];
    LAS unsigned char* lds = (LAS unsigned char*)lds_raw;
    cg::grid_group grid = cg::this_grid();
#define GRID_SYNC() do { asm volatile("s_waitcnt vmcnt(0) lgkmcnt(0)" ::: "memory"); __syncthreads(); grid.sync(); if (tid == 0) { __builtin_amdgcn_fence(__ATOMIC_ACQUIRE, "agent"); asm volatile("s_waitcnt vmcnt(0)" ::: "memory"); } __syncthreads(); } while (0)
    const int tid = threadIdx.x, lane = tid & 63, wave = __builtin_amdgcn_readfirstlane(tid >> 6);
    const int G = gridDim.x, bx = blockIdx.x, vcu = (G % 8 == 0) ? (bx % 8) * (G / 8) + bx / 8 : bx;
    const int gw = vcu * 8 + wave, NGW = G * 8;
    unsigned char* ws = a.ws;
    float* ropeC = (float*)(ws + WS_ROPE); float* ropeS = ropeC + SEQ * 8;
    bf16* WFI = (bf16*)(ws + WS_WFI); bf16* WFO = (bf16*)(ws + WS_WFO); bf16* WIN = (bf16*)(ws + WS_WIN);
    bf16* WPA = (bf16*)(ws + WS_WPA); bf16* WPR = (bf16*)(ws + WS_WPR); bf16* WWO = (bf16*)(ws + WS_WWO);
    bf16* H = (bf16*)(ws + WS_H); bf16* ACT = (bf16*)(ws + WS_BIG); bf16* P = (bf16*)(ws + WS_BIG);
    bf16* O1 = (bf16*)(ws + WS_Y); bf16* O2 = O1 + PBUF; bf16* T1 = (bf16*)(ws + WS_Y);
    bf16* YA = P + PB_QA * PBUF; bf16* YR = P + PB_KA * PBUF;
    float* out = a.out;
    float* RS0 = (float*)(ws + WS_SS); float* SS1 = RS0 + M; float* SS2 = SS1 + M; float* SS3 = SS2 + M;
    LAS float* scr = (LAS float*)(lds + wave * 16384);
    using pg8::Gemm; using pg8::StaticOrder; using pg8::gemm_phase;
    for (int u = tid; u < (LDS_BYTES - RING_BYTES) / 4; u += 512) ((LAS unsigned*)(lds + RING_BYTES))[u] = 0u;
    __syncthreads();
#define XSYNC() xcd_barrier(bar)

    for (int i = bx * 512 + tid; i < (int)(WS_ZERO_BYTES / 4); i += G * 512) ((unsigned*)(ws + WS_BAR))[i] = 0u;
    conv_mat<1>(a.in[I_F1I], a.in[I_F1N], DM, 2 * DFF, WFI, scr, gw, NGW, lane);
    conv_mat<0>(a.in[I_F1O], nullptr, DFF, DM, WFO, scr, gw, NGW, lane);
    conv_mat<0>(a.in[I_WIN], a.in[I_MIXN], DM, 11264, WIN, scr, gw, NGW, lane);
    conv_mat<0>(a.in[I_WPA], nullptr, 1024, DM, WPA, scr, gw, NGW, lane);
    conv_mat<0>(a.in[I_WPR], nullptr, 1024, DM, WPR, scr, gw, NGW, lane);
    conv_mat<0>(a.in[I_WOUT], nullptr, DM, DM, WWO, scr, gw, NGW, lane);
    for (int id = bx * 512 + tid; id < SEQ * 8; id += G * 512) { const int pos = id >> 3, i = id & 7;
        const float inv = powf(500000.0f, -(float)(2 * i) / 16.0f); const float ang = (float)pos * inv; ropeC[id] = cosf(ang); ropeS[id] = sinf(ang); }
    prep_rows_bf16(a.in[I_X], RS0, H, gw, NGW, lane);
    GRID_SYNC();
    XcdBarrier bar = xcd_barrier_post((unsigned*)(ws + WS_BAR), (volatile LAS unsigned*)(lds + RING_BYTES + 64));
    { Gemm g{H, WFI, M, 2 * DFF, DM}; StaticOrder S; S.init(M, 2 * DFF, G, bx); epi::EpiSwiglu<0> E{ACT, DFF, RS0};
      gemm_phase<epi::EpiSwiglu<0>, StaticOrder, true, true>(lds, g, S, E); }
    XSYNC();
    { Gemm g{ACT, WFO, M, DM, DFF}; StaticOrder S; S.init(M, DM, G, bx); epi::EpiResid<1, 1, true> E{a.in[I_X], out, ws};
      gemm_phase<epi::EpiResid<1, 1, true>, StaticOrder, true, true>(lds, g, S, E); }
    XSYNC();
    { Gemm g{H, WIN, M, 11264, DM}; StaticOrder S; S.init(M, 11264, G, bx); epi::EpiMix E{ws, a.in[I_LBRAW]};
      gemm_phase<epi::EpiMix, StaticOrder, true, true>(lds, g, S, E); }
    XSYNC();
    for (int u = vcu; u < 256; u += G) { const int pr = u & 3, bh = u >> 2, b = bh >> 3, h = bh & 7;
        hg::hgrn_unit(lds, b, h, pr, P + PB_QR * PBUF, (const _Float16*)(P + PB_LF * PBUF), P + PB_IO * PBUF, (bf16*)(ws + WS_OR));
        for (int j = 0; j < 2; ++j)
            for (int half = 0; half < 2; ++half)
                for (int e = 0; e < 2; ++e) { const int qb = e == 0 ? 7 - pr : pr;
                    attn_body::attn_unit<8>(b, 2 * h + j, 2 * h + half, qb, (const attn_body::bf16*)(P + PB_QA * PBUF), (const attn_body::bf16*)(P + PB_KA * PBUF), (const attn_body::bf16*)(P + PB_VA * PBUF),
                                            (attn_body::bf16*)(j == 0 ? O1 : O2), (char*)lds_raw); }
    }
    XSYNC();
    { const float d1 = wave_sum(a.in[I_LQ1][lane] * a.in[I_LK1][lane]), d2 = wave_sum(a.in[I_LQ2][lane] * a.in[I_LK2][lane]);
      const float lam = fexp(d1) - fexp(d2) + 0.2f;
      combine_rows(O1, O2, (const bf16*)(ws + WS_OR), P + PB_G * PBUF, YA, YR, lam, a.in[I_SUBLN], a.in[I_GNORM], gw, NGW, lane); }
    XSYNC();
    { StaticOrder S; S.init(M, DM, G, bx); const unsigned char* GA = ws + WS_WFI; const unsigned char* GB = GA + (size_t)M * DM;
      { Gemm g{YA, WPA, M, DM, 1024}; epi::EpiGate<0> E{T1, GA}; gemm_phase<epi::EpiGate<0>, StaticOrder, true, true>(lds, g, S, E); }
      { Gemm g{YR, WPR, M, DM, 1024}; epi::EpiGate<1> E{T1, GB}; gemm_phase<epi::EpiGate<1>, StaticOrder, true, true>(lds, g, S, E); } }
    XSYNC();
    conv_mat<1>(a.in[I_F2I], a.in[I_F2N], DM, 2 * DFF, WFI, scr, gw, NGW, lane);
    conv_mat<0>(a.in[I_F2O], nullptr, DFF, DM, WFO, scr, gw, NGW, lane);
    asm volatile("s_waitcnt vmcnt(0) lgkmcnt(0)" ::: "memory"); __syncthreads();
    { Gemm g{T1, WWO, M, DM, DM}; StaticOrder S; S.init(M, DM, G, bx); epi::EpiResid<1, 2, false> E{out, out, ws};
      gemm_phase<epi::EpiResid<1, 2, false>, StaticOrder, true, true>(lds, g, S, E); }
    XSYNC();
    { Gemm g{H, WFI, M, 2 * DFF, DM}; StaticOrder S; S.init(M, 2 * DFF, G, bx); epi::EpiSwiglu<1> E{ACT, DFF, SS2};
      gemm_phase<epi::EpiSwiglu<1>, StaticOrder, true, true>(lds, g, S, E); }
    XSYNC();
    if (G == 256) {
      Gemm g{ACT, WFO, M, DM, DFF}; epi::PanelOrder S{vcu}; epi::EpiFinal E{out, ws, a.in[I_FINN]};
      gemm_phase<epi::EpiFinal, epi::PanelOrder, true, true>(lds, g, S, E);
    } else {
      { Gemm g{ACT, WFO, M, DM, DFF}; StaticOrder S; S.init(M, DM, G, bx); epi::EpiResid<2, 3, true> E{out, out, ws};
        gemm_phase<epi::EpiResid<2, 3, true>, StaticOrder, true, true>(lds, g, S, E); }
      XSYNC();
      norm_rows_f32_inplace(out, SS3, a.in[I_FINN], gw, NGW, lane);
    }
}

extern "C" void kernel_launch(void* const* d_in, const int* in_sizes, int n_in, void* d_out, int out_size, void* d_ws, size_t ws_size, hipStream_t stream) {
    static int grid = 0;
    if (grid == 0) {
        if (n_in != 20 || out_size != M * DM || ws_size < WS_END) { fprintf(stderr, "kernel_launch: unexpected shapes (n_in %d out %d ws %zu)\n", n_in, out_size, ws_size); grid = -1; return; }
        int dev = 0, cus = 0, per_cu = 0;
        hipGetDevice(&dev); hipDeviceGetAttribute(&cus, hipDeviceAttributeMultiprocessorCount, dev);
        if (hipFuncSetAttribute((const void*)fwd_megakernel, hipFuncAttributeMaxDynamicSharedMemorySize, LDS_BYTES) != hipSuccess) { fprintf(stderr, "kernel_launch: hipFuncSetAttribute failed\n"); grid = -1; return; }
        if (hipOccupancyMaxActiveBlocksPerMultiprocessor(&per_cu, (const void*)fwd_megakernel, 512, LDS_BYTES) != hipSuccess || per_cu < 1) { fprintf(stderr, "kernel_launch: occupancy query says %d\n", per_cu); per_cu = 1; }
        (void)hipGetLastError();
        grid = cus * 1;
    }
    if (grid < 0) return;
    Args a{};
    for (int i = 0; i < 20; ++i) a.in[i] = (const float*)d_in[i];
    a.out = (float*)d_out; a.ws = (unsigned char*)d_ws;
    void* args[] = {&a};
    hipError_t e = hipLaunchCooperativeKernel((const void*)fwd_megakernel, dim3(grid), dim3(512), args, LDS_BYTES, stream);
    if (e != hipSuccess) fprintf(stderr, "cooperative launch failed: %s (grid %d)\n", hipGetErrorString(e), grid);
}
```
